# Optimizing an MI355X kernel written in HIP

```python
import jax, jax.numpy as jnp
from jax import lax
import numpy as np

D_MODEL = 1024
BATCH = 8
SEQ = 2048
DEPTH = 2

D_MIX = D_MODEL
HEAD_DIM = 64
RWKV_HEADS = 6
D_RWKV = RWKV_HEADS * HEAD_DIM
DECAY_LORA = 64
AAA_LORA = 64
GATE_LORA = 128
RWKV_LNX_EPS = 64e-5
MOBA_HEADS = 6
D_MOBA = MOBA_HEADS * HEAD_DIM
MOBA_BLOCK = 256
MOBA_TOPK = 3
MOBA_QCHUNK = 32
GMLP_GROUPS = 4
D_GMLP = GMLP_GROUPS * HEAD_DIM
GMLP_CHUNK = 128
D_FF = ((8 * D_MODEL // 3 + 255) // 256) * 256
NORM_EPS = 1e-6

A_COLS = 3 * D_RWKV + DECAY_LORA + AAA_LORA + GATE_LORA
B_COLS = 3 * D_MOBA
C_COLS = 2 * D_GMLP
D_IN = A_COLS + B_COLS + C_COLS

kernel_name = "hymba_rwkv7_moba_gmlp_block"


def rmsnorm(x, g):
    xf = x.astype(jnp.float32)
    y = xf * lax.rsqrt(jnp.mean(xf * xf, axis=-1, keepdims=True) + NORM_EPS)
    return (y * g.astype(jnp.float32)).astype(x.dtype)


def rwkv7_mixer(ya, mu, w0, w2, a0, a2, g2, k_k, k_a, r_k, lnx_g, lnx_b):
    B, S, _ = ya.shape
    H, D = RWKV_HEADS, HEAD_DIM
    prev = jnp.pad(ya, ((0, 0), (1, 0), (0, 0)))[:, :-1]
    ya = ya + mu * (prev - ya)
    r, k, v, wd, ad, gd = jnp.split(
        ya, [D_RWKV, 2 * D_RWKV, 3 * D_RWKV, 3 * D_RWKV + DECAY_LORA,
             3 * D_RWKV + DECAY_LORA + AAA_LORA], axis=-1)
    w = -jax.nn.softplus(-(w0 + jnp.tanh(wd) @ w2).astype(jnp.float32)) - 0.5
    decay = jnp.exp(-jnp.exp(w))
    a = jax.nn.sigmoid((a0 + ad @ a2).astype(jnp.float32))
    g = jax.nn.sigmoid(gd) @ g2
    heads = lambda t: t.astype(jnp.float32).reshape(B, S, H, D)
    kk = heads(k * k_k)
    kk = kk / jnp.maximum(jnp.linalg.norm(kk, axis=-1, keepdims=True), 1e-12)
    k = k * (1.0 + (a - 1.0) * k_a)
    rh, kh, vh, ah, dh = heads(r), heads(k), heads(v), heads(a), heads(decay)

    def step(state, inp):
        r_t, w_t, k_t, v_t, kk_t, a_t = inp
        sa = jnp.einsum('bhij,bhj->bhi', state, -kk_t)
        state = (state * w_t[:, :, None, :]
                 + sa[..., :, None] * (kk_t * a_t)[:, :, None, :]
                 + v_t[..., :, None] * k_t[:, :, None, :])
        return state, jnp.einsum('bhij,bhj->bhi', state, r_t)

    xs = tuple(jnp.moveaxis(t, 1, 0) for t in (rh, dh, kh, vh, kk, ah))
    s0 = jnp.zeros((B, H, D, D), jnp.float32)
    _, y = lax.scan(step, s0, xs)
    y = jnp.moveaxis(y, 0, 1)
    mean = jnp.mean(y, axis=-1, keepdims=True)
    var = jnp.mean(jnp.square(y - mean), axis=-1, keepdims=True)
    y = ((y - mean) * lax.rsqrt(var + RWKV_LNX_EPS)).reshape(B, S, D_RWKV)
    y = y * lnx_g + lnx_b
    bonus = jnp.sum(rh * kh * r_k.astype(jnp.float32), axis=-1, keepdims=True) * vh
    out = (y + bonus.reshape(B, S, D_RWKV)) * g.astype(jnp.float32)
    return out.astype(ya.dtype)


def moba_mixer(q, k, v):
    B, S, _ = q.shape
    H, D = MOBA_HEADS, HEAD_DIM
    q, k, v = (t.reshape(B, S, H, D).transpose(0, 2, 1, 3) for t in (q, k, v))
    nb = -(-S // MOBA_BLOCK)
    pad = nb * MOBA_BLOCK - S
    kb = jnp.pad(k, ((0, 0), (0, 0), (0, pad), (0, 0))).reshape(B, H, nb, MOBA_BLOCK, D)
    vb = jnp.pad(v, ((0, 0), (0, 0), (0, pad), (0, 0))).reshape(B, H, nb, MOBA_BLOCK, D)
    pos = jnp.arange(S)
    qblk = pos // MOBA_BLOCK
    own = jnp.broadcast_to(qblk[None, None, :, None], (B, H, S, 1))
    n_top = min(MOBA_TOPK, nb - 1)
    if n_top > 0:
        kbar = jnp.mean(kb.astype(jnp.float32), axis=3)
        blk_scores = jnp.einsum('bhsd,bhnd->bhsn', q.astype(jnp.float32), kbar)
        past = jnp.arange(nb)[None, :] < qblk[:, None]
        blk_scores = jnp.where(past, blk_scores, -jnp.inf)
        _, top = lax.top_k(blk_scores, n_top)
        sel = jnp.concatenate([top, own], axis=-1)
        sel_valid = jnp.concatenate(
            [top < qblk[None, None, :, None], jnp.ones_like(own, dtype=bool)], axis=-1)
    else:
        sel = own
        sel_valid = jnp.ones_like(own, dtype=bool)
    nsel = sel.shape[-1]
    nq = S // MOBA_QCHUNK
    q_c = jnp.moveaxis(q.reshape(B, H, nq, MOBA_QCHUNK, D), 2, 0)
    sel_c = jnp.moveaxis(sel.reshape(B, H, nq, MOBA_QCHUNK, nsel), 2, 0)
    val_c = jnp.moveaxis(sel_valid.reshape(B, H, nq, MOBA_QCHUNK, nsel), 2, 0)
    pos_c = pos.reshape(nq, MOBA_QCHUNK)
    bi = jnp.arange(B)[:, None, None, None]
    hi = jnp.arange(H)[None, :, None, None]
    scale = HEAD_DIM ** -0.5

    def attend(args):
        qq, ss, vv, pp = args
        kg = kb[bi, hi, ss]
        vg = vb[bi, hi, ss]
        logits = jnp.einsum('bhqd,bhqnkd->bhqnk', qq, kg).astype(jnp.float32) * scale
        kpos = ss[..., None] * MOBA_BLOCK + jnp.arange(MOBA_BLOCK)
        mask = vv[..., None] & (kpos <= pp[None, None, :, None, None])
        logits = jnp.where(mask, logits, -jnp.inf)
        p = jax.nn.softmax(logits.reshape(B, H, MOBA_QCHUNK, nsel * MOBA_BLOCK), axis=-1)
        p = p.reshape(B, H, MOBA_QCHUNK, nsel, MOBA_BLOCK).astype(vg.dtype)
        return jnp.einsum('bhqnk,bhqnkd->bhqd', p, vg)

    o = lax.map(attend, (q_c, sel_c, val_c, pos_c))
    o = jnp.moveaxis(o, 0, 2).reshape(B, H, S, D).transpose(0, 2, 1, 3)
    return o.reshape(B, S, D_MOBA)


def gmlp_mixer(u, v, ln_g, ln_b, w_s, b_s):
    B, S, _ = u.shape
    u = jax.nn.gelu(u)
    v = jax.nn.gelu(v)
    vf = v.astype(jnp.float32)
    mean = jnp.mean(vf, axis=-1, keepdims=True)
    var = jnp.mean(jnp.square(vf - mean), axis=-1, keepdims=True)
    v = (((vf - mean) * lax.rsqrt(var + NORM_EPS)) * ln_g + ln_b).astype(u.dtype)
    nc = S // GMLP_CHUNK
    vc = v.reshape(B, nc, GMLP_CHUNK, GMLP_GROUPS, HEAD_DIM)
    tril = jnp.tril(jnp.ones((GMLP_CHUNK, GMLP_CHUNK), dtype=bool))
    w_causal = jnp.where(tril[None], w_s, 0.0)
    s = jnp.einsum('gts,bcsgd->bctgd', w_causal, vc) + b_s.T[:, :, None]
    return u * s.reshape(B, S, D_GMLP)


def setup_inputs(seed: int = 0) -> dict:
    key = jax.random.key(seed)
    ks = jax.random.split(key, 24)
    n = lambda k, shape, s: jax.random.normal(k, shape, jnp.float32) * s
    L = DEPTH
    return {
        "x": n(ks[0], (BATCH, SEQ, D_MODEL), 1.0),
        "pre_mix_g": 1.0 + n(ks[1], (L, D_MODEL), 0.02),
        "w_in": n(ks[2], (L, D_MODEL, D_IN), D_MODEL ** -0.5),
        "rwkv_mu": jax.random.uniform(ks[3], (L, A_COLS), jnp.float32),
        "rwkv_w0": jax.random.uniform(ks[4], (L, D_RWKV), jnp.float32, -5.0, 1.0),
        "rwkv_w2": n(ks[5], (L, DECAY_LORA, D_RWKV), 0.1),
        "rwkv_a0": n(ks[6], (L, D_RWKV), 0.1),
        "rwkv_a2": n(ks[7], (L, AAA_LORA, D_RWKV), 0.5 * AAA_LORA ** -0.5),
        "rwkv_g2": n(ks[8], (L, GATE_LORA, D_RWKV), GATE_LORA ** -0.5),
        "rwkv_k_k": 0.85 + n(ks[9], (L, D_RWKV), 0.02),
        "rwkv_k_a": 1.0 + n(ks[10], (L, D_RWKV), 0.02),
        "rwkv_r_k": n(ks[11], (L, RWKV_HEADS, HEAD_DIM), 0.1),
        "rwkv_lnx_g": 1.0 + n(ks[12], (L, D_RWKV), 0.02),
        "rwkv_lnx_b": n(ks[13], (L, D_RWKV), 0.02),
        "gmlp_ln_g": 1.0 + n(ks[14], (L, D_GMLP), 0.02),
        "gmlp_ln_b": n(ks[15], (L, D_GMLP), 0.02),
        "gmlp_w_s": n(ks[16], (L, GMLP_GROUPS, GMLP_CHUNK, GMLP_CHUNK), GMLP_CHUNK ** -0.5),
        "gmlp_b_s": 1.0 + n(ks[17], (L, GMLP_GROUPS, GMLP_CHUNK), 0.01),
        "w_out": n(ks[18], (L, D_MIX, D_MODEL), D_MIX ** -0.5),
        "post_mix_g": 1.0 + n(ks[19], (L, D_MODEL), 0.02),
        "pre_ffn_g": 1.0 + n(ks[20], (L, D_MODEL), 0.02),
        "w_ffn_in": n(ks[21], (L, D_MODEL, 2 * D_FF), D_MODEL ** -0.5),
        "w_ffn_out": n(ks[22], (L, D_FF, D_MODEL), D_FF ** -0.5),
        "post_ffn_g": 1.0 + n(ks[23], (L, D_MODEL), 0.02),
    }


def reference(x, pre_mix_g, w_in, rwkv_mu, rwkv_w0, rwkv_w2, rwkv_a0, rwkv_a2, rwkv_g2,
              rwkv_k_k, rwkv_k_a, rwkv_r_k, rwkv_lnx_g, rwkv_lnx_b, gmlp_ln_g, gmlp_ln_b,
              gmlp_w_s, gmlp_b_s, w_out, post_mix_g, pre_ffn_g, w_ffn_in, w_ffn_out,
              post_ffn_g):
    for l in range(DEPTH):
        h = rmsnorm(x, pre_mix_g[l])
        proj = h @ w_in[l]
        ya, yb, yc = jnp.split(proj, [A_COLS, A_COLS + B_COLS], axis=-1)
        a_out = rwkv7_mixer(ya, rwkv_mu[l], rwkv_w0[l], rwkv_w2[l], rwkv_a0[l],
                            rwkv_a2[l], rwkv_g2[l], rwkv_k_k[l], rwkv_k_a[l],
                            rwkv_r_k[l], rwkv_lnx_g[l], rwkv_lnx_b[l])
        qb, kb, vb = jnp.split(yb, 3, axis=-1)
        b_out = moba_mixer(qb, kb, vb)
        u, v = jnp.split(yc, 2, axis=-1)
        c_out = gmlp_mixer(u, v, gmlp_ln_g[l], gmlp_ln_b[l], gmlp_w_s[l], gmlp_b_s[l])
        mix = jnp.concatenate([a_out, b_out, c_out], axis=-1) @ w_out[l]
        x = x + rmsnorm(mix, post_mix_g[l])
        h = rmsnorm(x, pre_ffn_g[l])
        gate, up = jnp.split(h @ w_ffn_in[l], 2, axis=-1)
        f = (jax.nn.silu(gate) * up) @ w_ffn_out[l]
        x = x + rmsnorm(f, post_ffn_g[l])
    return x
```

```cpp
#include <hip/hip_runtime.h>
#include <hip/hip_cooperative_groups.h>
#include <cstdio>
namespace cg = cooperative_groups;
namespace pg8 {
#define PG8_LAS __attribute__((address_space(3)))
typedef unsigned short bf16_t;
typedef short bf16x8 __attribute__((ext_vector_type(8)));
typedef float f32x4 __attribute__((ext_vector_type(4)));
typedef unsigned u32x4 __attribute__((ext_vector_type(4)));
constexpr int BM = 256, BK = 64, HALF = 128, HTB = HALF * BK * 2  , STAGE_BYTES = 8 * HTB, NXCD = 8, WGM = 8;

__host__ __device__ __forceinline__ int lds_byte(int r, int c) { const int st = (r >> 4) * 2 + (c >> 5), rr = r & 15, cc = c & 31, ob = rr * 64 + cc * 2; return st * 1024 + (ob ^ (((ob >> 9) & 1) << 5)); }
__host__ __device__ __forceinline__ void stage_rc(int b, int& R, int& C) { const int st = b / 1024, sb = b % 1024, swz = sb ^ (((sb >> 9) & 1) << 5); R = (st >> 1) * 16 + swz / 64; C = (st & 1) * 32 + (swz % 64) / 2; }
__host__ __device__ __forceinline__ int perm32(int rho) { const int n = rho >> 4, i = rho & 15; return 8 * (i >> 2) + 4 * n + (i & 3); }

struct Unit { int pm, pn; };
struct Gemm { const bf16_t* A; const bf16_t* Bt; int M, N, K; };

struct StaticOrder {
    int nM, nN, nwg, G, c;
    __host__ __device__ void init(int M, int N, int G_, int c_) { nM = M / BM; nN = N / BM; nwg = nM * nN; G = G_; c = c_; }
    __host__ __device__ bool next(int i, Unit& u) const {
        const long L = (long)i * G + c; if (L >= nwg) return false;
        int wgid = (int)L; { const int q = nwg / NXCD, r = nwg % NXCD, xcd = wgid % NXCD, off = wgid / NXCD; wgid = (xcd < r ? xcd * (q + 1) : r * (q + 1) + (xcd - r) * q) + off; }
        const int nig = WGM * nN, gid = wgid / nig, fm = gid * WGM, gsz = (nM - fm) < WGM ? (nM - fm) : WGM;
        u.pm = fm + ((wgid % nig) % gsz); u.pn = (wgid % nig) / gsz; return true;
    }
    __device__ __forceinline__ void a_ready(const Unit&) const {}
    __device__ __forceinline__ void done(const Unit&) const {}
};
__device__ __forceinline__ unsigned cvt_pk_bf16(float lo, float hi) { unsigned r; asm volatile("v_cvt_pk_bf16_f32 %0, %1, %2" : "=v"(r) : "v"(lo), "v"(hi)); return r; }
typedef float f32x2 __attribute__((ext_vector_type(2)));
struct EpiF32 {
    static constexpr bool PERM = false, AFTER_DRAIN = false;
    float* C; int ldc;
    __device__ __forceinline__ void operator()(const f32x4 (&acc)[2][2][4][2], const Unit& u, int wr, int wc, int fr, int fq) const {
        const int row0 = u.pm * BM + wr * 64 + fr, col0 = u.pn * BM + wc * 32 + 4 * fq;
#pragma unroll
        for (int ai = 0; ai < 2; ++ai)
#pragma unroll
            for (int m = 0; m < 4; ++m) { float* rowp = C + (size_t)(row0 + ai * HALF + m * 16) * ldc + col0;
#pragma unroll
                for (int bj = 0; bj < 2; ++bj)
#pragma unroll
                    for (int n = 0; n < 2; ++n) *(f32x4*)(rowp + bj * HALF + n * 16) = acc[ai][bj][m][n]; }
    }
};
struct EpiProj {
    static constexpr bool PERM = true, AFTER_DRAIN = false;
    bf16_t *RW, *QKV, *GM;
    __device__ __forceinline__ void operator()(const f32x4 (&acc)[2][2][4][2], const Unit& u, int wr, int wc, int fr, int fq) const {
        const int row0 = u.pm * BM + wr * 64 + fr;
#pragma unroll
        for (int bj = 0; bj < 2; ++bj) {
            const int hh = 2 * u.pn + bj; bf16_t* base; int ld, c0;
            if (hh < 11) { base = RW; ld = 1408; c0 = 128 * hh; } else if (hh < 20) { base = QKV; ld = 1152; c0 = 128 * (hh - 11); } else { base = GM; ld = 512; c0 = 128 * (hh - 20); }
            const int col = c0 + wc * 32 + 8 * fq;
#pragma unroll
            for (int ai = 0; ai < 2; ++ai)
#pragma unroll
                for (int m = 0; m < 4; ++m) { const f32x4 v0 = acc[ai][bj][m][0], v1 = acc[ai][bj][m][1];
                    u32x4 w; w.x = cvt_pk_bf16(v0[0], v0[1]); w.y = cvt_pk_bf16(v0[2], v0[3]); w.z = cvt_pk_bf16(v1[0], v1[1]); w.w = cvt_pk_bf16(v1[2], v1[3]);
                    *(u32x4*)(base + (size_t)(row0 + ai * HALF + m * 16) * ld + col) = w; }
        }
    }
};
__device__ __forceinline__ float silu_mul(float g, float u) { return g * __builtin_amdgcn_rcpf(1.0f + __expf(-g)) * u; }
struct EpiSwiglu {
    static constexpr bool PERM = true, AFTER_DRAIN = false;
    bf16_t* FF;
    __device__ __forceinline__ void operator()(const f32x4 (&acc)[2][2][4][2], const Unit& u, int wr, int wc, int fr, int fq) const {
        const int row0 = u.pm * BM + wr * 64 + fr, col = 128 * u.pn + wc * 32 + 8 * fq;
#pragma unroll
        for (int ai = 0; ai < 2; ++ai)
#pragma unroll
            for (int m = 0; m < 4; ++m) { const f32x4 g0 = acc[ai][0][m][0], g1 = acc[ai][0][m][1], u0 = acc[ai][1][m][0], u1 = acc[ai][1][m][1];
                u32x4 w; w.x = cvt_pk_bf16(silu_mul(g0[0], u0[0]), silu_mul(g0[1], u0[1])); w.y = cvt_pk_bf16(silu_mul(g0[2], u0[2]), silu_mul(g0[3], u0[3]));
                w.z = cvt_pk_bf16(silu_mul(g1[0], u1[0]), silu_mul(g1[1], u1[1])); w.w = cvt_pk_bf16(silu_mul(g1[2], u1[2]), silu_mul(g1[3], u1[3]));
                *(u32x4*)(FF + (size_t)(row0 + ai * HALF + m * 16) * 2816 + col) = w; }
    }
};
template <class Epi, class Sched, bool STAMP = false>
__device__ __forceinline__ void gemm_phase(PG8_LAS unsigned char* lds, const Gemm g, const Sched& S, const Epi& E, unsigned long long* stamps) {
    int tid_ = threadIdx.x; asm volatile("" : "+v"(tid_));
    const int tid = tid_, wid = __builtin_amdgcn_readfirstlane(tid >> 6), lane = tid & 63, wr = wid >> 2, wc = wid & 3, fr = lane & 15, fq = lane >> 4;
    const int K = g.K, nt = K / BK;
    int ts_lo = 0, ts_hi = 0, nts = 0; const unsigned long long rt_entry = STAMP ? (unsigned long long)wall_clock64() : 0ull;
#define PG8_STAMP() do { if (STAMP && wid == 0 && nts < 64) { const unsigned long long _c = (unsigned long long)clock64(); \
        ts_lo = (lane == nts) ? (int)(unsigned)_c : ts_lo; ts_hi = (lane == nts) ? (int)(unsigned)(_c >> 32) : ts_hi; ++nts; } } while (0)
    PG8_STAMP();
    unsigned voffA[2], voffB[2];
#pragma unroll
    for (int i = 0; i < 2; ++i) { int R, C; stage_rc(tid * 16 + i * 8192, R, C); const int Rb = Epi::PERM ? ((R & ~31) + perm32(R & 31)) : R;
        voffA[i] = (unsigned)(R * K + C) * 2u; voffB[i] = (unsigned)(Rb * K + C) * 2u; }
    const size_t kstep = (size_t)(BK * 2);
    const size_t hstep = (size_t)HALF * K * 2;
    const size_t tstep = 2 * hstep;
    const unsigned ldsw = (unsigned)wid * 1024u;
    const int aoff = lds_byte(wr * 64 + fr, fq * 8), boff = lds_byte(wc * 32 + fr, fq * 8);
#define PG8_SA(b, h) (((b) * 2 + (h)) * HTB)
#define PG8_SB(b, h) ((4 + (b) * 2 + (h)) * HTB)
#define PG8_STAGE(bufoff, gbase, voff) do { _Pragma("unroll") for (int _i = 0; _i < 2; ++_i) \
        __builtin_amdgcn_global_load_lds((const unsigned*)((const char*)(gbase) + (voff)[_i]), (PG8_LAS unsigned*)(lds + (bufoff) + ldsw + _i * 8192), 16, 0, 0); } while (0)
#define PG8_LDA(dst, b, h) do { _Pragma("unroll") for (int m = 0; m < 4; ++m) _Pragma("unroll") for (int k = 0; k < 2; ++k) dst[m][k] = *(const PG8_LAS bf16x8*)(lds + PG8_SA(b, h) + aoff + m * 2048 + k * 1024); } while (0)
#define PG8_LDB(dst, b, h) do { _Pragma("unroll") for (int n = 0; n < 2; ++n) _Pragma("unroll") for (int k = 0; k < 2; ++k) dst[n][k] = *(const PG8_LAS bf16x8*)(lds + PG8_SB(b, h) + boff + n * 2048 + k * 1024); } while (0)
#define PG8_MMA(ai, bj, At, Bt) do { __builtin_amdgcn_s_setprio(1); _Pragma("unroll") for (int m = 0; m < 4; ++m) _Pragma("unroll") for (int n = 0; n < 2; ++n) _Pragma("unroll") for (int k = 0; k < 2; ++k) \
        acc[ai][bj][m][n] = __builtin_amdgcn_mfma_f32_16x16x32_bf16(Bt[n][k], At[m][k], acc[ai][bj][m][n], 0, 0, 0); __builtin_amdgcn_s_setprio(0); } while (0)
#define PG8_WAIT_V(n) asm volatile("s_waitcnt vmcnt(" #n ")" ::: "memory")
#define PG8_WAIT_L(n) asm volatile("s_waitcnt lgkmcnt(" #n ")" ::: "memory")
#define PG8_BAR __builtin_amdgcn_s_barrier()
#define PG8_SCHED __builtin_amdgcn_sched_barrier(0)
    Unit cur, nxt; int ui = 0;
    if (!S.next(0, cur)) return;
    f32x4 acc[2][2][4][2];
#pragma unroll
    for (int a = 0; a < 2; ++a)
#pragma unroll
        for (int b = 0; b < 2; ++b)
#pragma unroll
            for (int m = 0; m < 4; ++m)
#pragma unroll
                for (int n = 0; n < 2; ++n) acc[a][b][m][n] = (f32x4){0.f, 0.f, 0.f, 0.f};
    bf16x8 At[4][2], B0[2][2], B1[2][2];
    const char* cA = (const char*)g.A + (size_t)cur.pm * tstep; const char* cB = (const char*)g.Bt + (size_t)cur.pn * tstep;
    S.a_ready(cur);
    PG8_STAGE(PG8_SB(0, 0), cB, voffB); PG8_STAGE(PG8_SA(0, 0), cA, voffA); PG8_STAGE(PG8_SB(0, 1), cB + hstep, voffB); PG8_STAGE(PG8_SA(0, 1), cA + hstep, voffA);
    if (wr == 1) PG8_BAR;
    PG8_WAIT_V(4); PG8_BAR;
    PG8_STAGE(PG8_SB(1, 0), cB + kstep, voffB); PG8_STAGE(PG8_SA(1, 0), cA + kstep, voffA); PG8_STAGE(PG8_SB(1, 1), cB + hstep + kstep, voffB);
    PG8_WAIT_V(6); PG8_BAR;
    PG8_STAMP();
    for (;;) {
        const bool has_next = S.next(ui + 1, nxt);
        const char* nA = has_next ? (const char*)g.A + (size_t)nxt.pm * tstep : cA; const char* nB = has_next ? (const char*)g.Bt + (size_t)nxt.pn * tstep : cB;
        for (int t = 0; t < nt; t += 2) {
            const bool last = (t == nt - 2);
            const char* a1 = cA + (size_t)(t + 1) * kstep;
            const char* a2 = last ? nA : cA + (size_t)(t + 2) * kstep; const char* b2 = last ? nB : cB + (size_t)(t + 2) * kstep;
            const char* a3 = a2 + kstep; const char* b3 = b2 + kstep;
            if (last && has_next) S.a_ready(nxt);
            PG8_LDB(B0, 0, 0); PG8_SCHED; PG8_LDA(At, 0, 0); PG8_STAGE(PG8_SA(1, 1), a1 + hstep, voffA);
            PG8_WAIT_L(8); PG8_BAR; PG8_WAIT_L(0); PG8_MMA(0, 0, At, B0); PG8_BAR; PG8_SCHED;
            PG8_LDB(B1, 0, 1); PG8_STAGE(PG8_SB(0, 0), b2, voffB);
            PG8_BAR; PG8_WAIT_L(0); PG8_MMA(0, 1, At, B1); PG8_BAR;
            PG8_LDA(At, 0, 1); PG8_STAGE(PG8_SA(0, 0), a2, voffA);
            PG8_BAR; PG8_WAIT_L(0); PG8_MMA(1, 0, At, B0); PG8_BAR; PG8_SCHED;
            PG8_STAGE(PG8_SB(0, 1), b2 + hstep, voffB);
            PG8_WAIT_V(6); PG8_BAR; PG8_MMA(1, 1, At, B1); PG8_BAR;
            PG8_LDB(B0, 1, 0); PG8_SCHED; PG8_LDA(At, 1, 0); PG8_STAGE(PG8_SA(0, 1), a2 + hstep, voffA);
            PG8_WAIT_L(8); PG8_BAR; PG8_WAIT_L(0); PG8_MMA(0, 0, At, B0); PG8_BAR; PG8_SCHED;
            PG8_LDB(B1, 1, 1); PG8_STAGE(PG8_SB(1, 0), b3, voffB);
            PG8_BAR; PG8_WAIT_L(0); PG8_MMA(0, 1, At, B1); PG8_BAR;
            PG8_LDA(At, 1, 1); PG8_STAGE(PG8_SA(1, 0), a3, voffA);
            PG8_BAR; PG8_WAIT_L(0); PG8_MMA(1, 0, At, B0); PG8_BAR; PG8_SCHED;
            PG8_STAGE(PG8_SB(1, 1), b3 + hstep, voffB);
            PG8_WAIT_V(6); PG8_BAR; PG8_MMA(1, 1, At, B1); PG8_BAR;
        }
        PG8_STAMP();
        if constexpr (!Epi::AFTER_DRAIN) { E(acc, cur, wr, wc, fr, fq); S.done(cur); }
        PG8_STAMP();
        if (!has_next) break;
#pragma unroll
        for (int a = 0; a < 2; ++a)
#pragma unroll
            for (int b = 0; b < 2; ++b)
#pragma unroll
                for (int m = 0; m < 4; ++m)
#pragma unroll
                    for (int n = 0; n < 2; ++n) acc[a][b][m][n] = (f32x4){0.f, 0.f, 0.f, 0.f};
        cur = nxt; cA = nA; cB = nB; ++ui;
    }
    PG8_WAIT_V(0);
    if (wr == 0) PG8_BAR;
    PG8_BAR;
    if constexpr (Epi::AFTER_DRAIN) { E.fused(acc, cur, wr, wc, fr, fq, lds, wid, lane); S.done(cur); }
    PG8_STAMP();
    if (STAMP && wid == 0) { stamps[lane] = lane < nts ? (((unsigned long long)(unsigned)ts_hi << 32) | (unsigned)ts_lo) : 0ull;
        if (lane == 62) stamps[62] = rt_entry; if (lane == 63) stamps[63] = (unsigned long long)wall_clock64(); }
#undef PG8_STAMP
#undef PG8_SA
#undef PG8_SB
#undef PG8_STAGE
#undef PG8_LDA
#undef PG8_LDB
#undef PG8_MMA
#undef PG8_WAIT_V
#undef PG8_WAIT_L
#undef PG8_BAR
#undef PG8_SCHED
}
}
#define LAS __attribute__((address_space(3)))
typedef unsigned short bf16_t;
typedef short bf16x8 __attribute__((ext_vector_type(8)));
typedef float f32x4 __attribute__((ext_vector_type(4)));
typedef unsigned u32x4 __attribute__((ext_vector_type(4)));
typedef unsigned u32x2 __attribute__((ext_vector_type(2)));
using pg8::cvt_pk_bf16;
constexpr int MTOK = 16384, DM = 1024, SEQ = 2048, NB = 8, NH = 6, DFF = 2816, NLAYER = 2;
constexpr size_t MiB = 1u << 20;
constexpr size_t WS_CTL = 0, WS_KBAR = 65536, WS_RK = 262144, WS_W = 1 * MiB;
constexpr size_t WL_IN = 0, WL_OUT = WL_IN + 3072ull * 1024 * 2, WL_FF = WL_OUT + 1024ull * 1024 * 2, WL_FF2 = WL_FF + 5632ull * 1024 * 2, WL_W2 = WL_FF2 + 1024ull * 2816 * 2,
                 WL_A2 = WL_W2 + 384 * 64 * 2, WL_G2 = WL_A2 + 384 * 64 * 2, WL_SIZE = WL_G2 + 384 * 128 * 2;
static_assert(WS_W + 2 * WL_SIZE <= 52 * MiB, "weights region");
constexpr size_t WS_RW = 52 * MiB, WS_QKV = 96 * MiB, WS_GM = 132 * MiB, WS_U = 148 * MiB, WS_XB = 220 * MiB, WS_END = 252 * MiB;
constexpr size_t WS_Y = WS_RW, WS_MIXO = WS_RW, WS_FF = WS_RW, WS_XA = WS_U, WS_MIXO2 = WS_U + 8 * MiB, WS_OPS = WS_U, WS_MIXCAT = WS_XB;
constexpr int LDS_BYTES = 131072;

__device__ __forceinline__ float bf2f(bf16_t b) { return __uint_as_float(((unsigned)b) << 16); }
__device__ __forceinline__ float bflo(unsigned u) { return __uint_as_float(u << 16); }
__device__ __forceinline__ float bfhi(unsigned u) { return __uint_as_float(u & 0xffff0000u); }
__device__ __forceinline__ float wave_sum(float v) {
#pragma unroll
    for (int o = 1; o < 64; o <<= 1) v += __shfl_xor(v, o);
    return v;
}
template <int CTRL> __device__ __forceinline__ float dppf(float x) { return __int_as_float(__builtin_amdgcn_update_dpp(0, __float_as_int(x), CTRL, 0xF, 0xF, true)); }
__device__ __forceinline__ float ar16(float x) {
    x += dppf<0xB1>(x); x += dppf<0x4E>(x); x += dppf<0x141>(x); x += dppf<0x140>(x); return x;
}
__device__ __forceinline__ float fsigmoid(float x) { return 1.0f / (1.0f + __expf(-x)); }
__device__ __forceinline__ float ftanh(float x) { const float e = __expf(-2.0f * fabsf(x)); const float t = (1.0f - e) / (1.0f + e); return x < 0.f ? -t : t; }
__device__ __forceinline__ float fgelu(float x) { return 0.5f * x * (1.0f + ftanh(0.7978845608028654f * (x + 0.044715f * x * x * x))); }
__device__ __forceinline__ bf16x8 pack8(const float* f) { u32x4 w; w.x = cvt_pk_bf16(f[0], f[1]); w.y = cvt_pk_bf16(f[2], f[3]); w.z = cvt_pk_bf16(f[4], f[5]); w.w = cvt_pk_bf16(f[6], f[7]); return __builtin_bit_cast(bf16x8, w); }
__device__ __forceinline__ void unpack8(u32x4 w, float* f) { f[0] = bflo(w.x); f[1] = bfhi(w.x); f[2] = bflo(w.y); f[3] = bfhi(w.y); f[4] = bflo(w.z); f[5] = bfhi(w.z); f[6] = bflo(w.w); f[7] = bfhi(w.w); }
__device__ __forceinline__ void unpack4(u32x2 w, float* f) { f[0] = bflo(w.x); f[1] = bfhi(w.x); f[2] = bflo(w.y); f[3] = bfhi(w.y); }
__device__ __forceinline__ u32x2 pack4(float a, float b, float c, float d) { u32x2 w; w.x = cvt_pk_bf16(a, b); w.y = cvt_pk_bf16(c, d); return w; }
#define LDS_WAIT() asm volatile("s_waitcnt lgkmcnt(0)" ::: "memory")

struct Params { const float* in[24]; float* out; unsigned char* ws; };

__device__ __forceinline__ void transpose_item(const float* W, int K, int N, bf16_t* WT, int k0, int n0, int drow, LAS float* scr, int lane) {
#pragma unroll 8
    for (int i = 0; i < 32; ++i) { const int kk = 2 * i + (lane >> 5); scr[kk * 33 + (lane & 31)] = W[(size_t)(k0 + kk) * N + n0 + (lane & 31)]; }
    LDS_WAIT();
    const int c = lane & 7;
#pragma unroll
    for (int j = 0; j < 4; ++j) { const int n = (lane >> 3) + 8 * j; const LAS float* s = scr + (8 * c) * 33 + n;
        u32x4 o; o.x = cvt_pk_bf16(s[0 * 33], s[1 * 33]); o.y = cvt_pk_bf16(s[2 * 33], s[3 * 33]); o.z = cvt_pk_bf16(s[4 * 33], s[5 * 33]); o.w = cvt_pk_bf16(s[6 * 33], s[7 * 33]);
        *(u32x4*)(WT + (size_t)(drow + n) * K + k0 + 8 * c) = o; }
    LDS_WAIT();
}
__device__ __forceinline__ void transpose_mat(const float* W, int K, int N, bf16_t* WT, int item, bool swiglu, LAS float* scr, int lane) {
    const int nblk = N / 32, kb = item / nblk, nb = item % nblk, n0 = 32 * nb;
    int drow = n0;
    if (swiglu) { if (n0 < DFF) drow = 256 * (n0 / 128) + (n0 % 128); else { const int q = n0 - DFF; drow = 256 * (q / 128) + 128 + (q % 128); } }
    transpose_item(W, K, N, WT, 64 * kb, n0, drow, scr, lane);
}
__device__ __forceinline__ void p0_weights(const float* w_in, const float* w_out, const float* w_ffi, const float* w_ffo, const float* w2, const float* a2, const float* g2, unsigned char* ws, LAS unsigned char* lds, int gw, int ngw, int wave, int lane) {
    LAS float* scr = (LAS float*)(lds + wave * 8448);
    constexpr int I_IN = 16 * 96, I_OUT = 16 * 32, I_FF = 16 * 176, I_FF2 = 44 * 32, I_W2 = 12, I_A2 = 12, I_G2 = 24, I_L = I_IN + I_OUT + I_FF + I_FF2 + I_W2 + I_A2 + I_G2;
    for (int it = gw; it < NLAYER * I_L; it += ngw) {
        const int l = it / I_L; int r = it % I_L; unsigned char* wl = ws + WS_W + (size_t)l * WL_SIZE;
        if (r < I_IN) { transpose_mat(w_in + (size_t)l * 1024 * 3072, 1024, 3072, (bf16_t*)(wl + WL_IN), r, false, scr, lane); continue; } r -= I_IN;
        if (r < I_OUT) { transpose_mat(w_out + (size_t)l * 1024 * 1024, 1024, 1024, (bf16_t*)(wl + WL_OUT), r, false, scr, lane); continue; } r -= I_OUT;
        if (r < I_FF) { transpose_mat(w_ffi + (size_t)l * 1024 * 5632, 1024, 5632, (bf16_t*)(wl + WL_FF), r, true, scr, lane); continue; } r -= I_FF;
        if (r < I_FF2) { transpose_mat(w_ffo + (size_t)l * 2816 * 1024, 2816, 1024, (bf16_t*)(wl + WL_FF2), r, false, scr, lane); continue; } r -= I_FF2;
        if (r < I_W2) { transpose_mat(w2 + (size_t)l * 64 * 384, 64, 384, (bf16_t*)(wl + WL_W2), r, false, scr, lane); continue; } r -= I_W2;
        if (r < I_A2) { transpose_mat(a2 + (size_t)l * 64 * 384, 64, 384, (bf16_t*)(wl + WL_A2), r, false, scr, lane); continue; } r -= I_A2;
        transpose_mat(g2 + (size_t)l * 128 * 384, 128, 384, (bf16_t*)(wl + WL_G2), r, false, scr, lane);
    }
}
__device__ __forceinline__ void row_phase(const float* res, const float* add, const float* g_add, float* res_out, const float* g_xn, bf16_t* xn, int gw, int ngw, int lane) {
    for (int m = gw; m < MTOK; m += ngw) {
        const f32x4* xr = (const f32x4*)(res + (size_t)m * DM) + lane; f32x4 x[4];
#pragma unroll
        for (int j = 0; j < 4; ++j) x[j] = xr[64 * j];
        if (add) {
            const f32x4* ar = (const f32x4*)(add + (size_t)m * DM) + lane; f32x4 a[4]; float ss = 0.f;
#pragma unroll
            for (int j = 0; j < 4; ++j) { a[j] = ar[64 * j]; ss += (a[j].x * a[j].x + a[j].y * a[j].y) + (a[j].z * a[j].z + a[j].w * a[j].w); }
            const float rs = rsqrtf(wave_sum(ss) * (1.0f / DM) + 1e-6f);
            f32x4* orow = (f32x4*)(res_out + (size_t)m * DM) + lane;
#pragma unroll
            for (int j = 0; j < 4; ++j) { const f32x4 g = ((const f32x4*)g_add)[lane + 64 * j]; x[j] = x[j] + a[j] * rs * g; orow[64 * j] = x[j]; }
        }
        if (xn) {
            float ss = 0.f;
#pragma unroll
            for (int j = 0; j < 4; ++j) ss += (x[j].x * x[j].x + x[j].y * x[j].y) + (x[j].z * x[j].z + x[j].w * x[j].w);
            const float rs = rsqrtf(wave_sum(ss) * (1.0f / DM) + 1e-6f);
            u32x2* o8 = (u32x2*)(xn + (size_t)m * DM) + lane;
#pragma unroll
            for (int j = 0; j < 4; ++j) { const f32x4 g = ((const f32x4*)g_xn)[lane + 64 * j]; o8[64 * j] = pack4(x[j].x * rs * g.x, x[j].y * rs * g.y, x[j].z * rs * g.z, x[j].w * rs * g.w); }
        }
    }
}

struct Lay { const float *mu, *w0, *a0, *k_k, *k_a, *r_k, *lnx_g, *lnx_b, *gln_g, *gln_b, *gw_s, *gb_s; const bf16_t *w2T, *a2T, *g2T; };
__device__ __forceinline__ void shifted8(const bf16_t* row, bool hp, const float* mu, int col, float* o) {
    float c[8], p[8]; unpack8(*(const u32x4*)(row + col), c);
    if (hp) unpack8(*(const u32x4*)(row - 1408 + col), p); else {
#pragma unroll
        for (int i = 0; i < 8; ++i) p[i] = 0.f; }
    const f32x4 m0 = *(const f32x4*)(mu + col), m1 = *(const f32x4*)(mu + col + 4); const float mm[8] = {m0.x, m0.y, m0.z, m0.w, m1.x, m1.y, m1.z, m1.w};
#pragma unroll
    for (int i = 0; i < 8; ++i) o[i] = c[i] + mm[i] * (p[i] - c[i]);
}
__device__ __forceinline__ void shifted4(const bf16_t* row, bool hp, const float* mu, int col, float* o) {
    float c[4], p[4]; unpack4(*(const u32x2*)(row + col), c);
    if (hp) unpack4(*(const u32x2*)(row - 1408 + col), p); else { p[0] = p[1] = p[2] = p[3] = 0.f; }
    const f32x4 m0 = *(const f32x4*)(mu + col); const float mm[4] = {m0.x, m0.y, m0.z, m0.w};
#pragma unroll
    for (int i = 0; i < 4; ++i) o[i] = c[i] + mm[i] * (p[i] - c[i]);
}
__device__ __forceinline__ void rwkv_prep_task(const Lay& L, const bf16_t* RW, bf16_t* OPS, bf16_t* MIXCAT, float* RK, int task, int lane) {
    const int tg = task / NH, h = task % NH, fr = lane & 15, fq = lane >> 4;
    const int tok = tg * 16 + fr, s = tok & (SEQ - 1); const bool hp = s > 0;
    const bf16_t* row = RW + (size_t)tok * 1408;
    bf16x8 Aw[2], Aa[2], Ag[4]; float t8[8];
#pragma unroll
    for (int kk = 0; kk < 2; ++kk) { shifted8(row, hp, L.mu, 1152 + 32 * kk + 8 * fq, t8);
#pragma unroll
        for (int i = 0; i < 8; ++i) t8[i] = ftanh(t8[i]);
        Aw[kk] = pack8(t8); }
#pragma unroll
    for (int kk = 0; kk < 2; ++kk) { shifted8(row, hp, L.mu, 1216 + 32 * kk + 8 * fq, t8); Aa[kk] = pack8(t8); }
#pragma unroll
    for (int kk = 0; kk < 4; ++kk) { shifted8(row, hp, L.mu, 1280 + 32 * kk + 8 * fq, t8);
#pragma unroll
        for (int i = 0; i < 8; ++i) t8[i] = fsigmoid(t8[i]);
        Ag[kk] = pack8(t8); }
    const int bh = (tok >> 11) * NH + h;
    bf16_t* ops = OPS + ((size_t)bh * SEQ + s) * 384;
    float kkv[4][4], av[4][4]; float ssq = 0.f, rkp = 0.f;
#pragma unroll
    for (int ct = 0; ct < 4; ++ct) {
        const int wrow = 64 * h + 16 * ct + fr;
        f32x4 accw = {0.f, 0.f, 0.f, 0.f}, acca = {0.f, 0.f, 0.f, 0.f}, accg = {0.f, 0.f, 0.f, 0.f};
#pragma unroll
        for (int kk = 0; kk < 2; ++kk) {
            accw = __builtin_amdgcn_mfma_f32_16x16x32_bf16(*(const bf16x8*)(L.w2T + (size_t)wrow * 64 + 32 * kk + 8 * fq), Aw[kk], accw, 0, 0, 0);
            acca = __builtin_amdgcn_mfma_f32_16x16x32_bf16(*(const bf16x8*)(L.a2T + (size_t)wrow * 64 + 32 * kk + 8 * fq), Aa[kk], acca, 0, 0, 0); }
#pragma unroll
        for (int kk = 0; kk < 4; ++kk)
            accg = __builtin_amdgcn_mfma_f32_16x16x32_bf16(*(const bf16x8*)(L.g2T + (size_t)wrow * 128 + 32 * kk + 8 * fq), Ag[kk], accg, 0, 0, 0);
        const int cl = 16 * ct + 4 * fq, c0 = 64 * h + cl;
        float rs[4], ks[4], vs[4]; shifted4(row, hp, L.mu, c0, rs); shifted4(row, hp, L.mu, 384 + c0, ks); shifted4(row, hp, L.mu, 768 + c0, vs);
        const f32x4 w0 = *(const f32x4*)(L.w0 + c0), a0 = *(const f32x4*)(L.a0 + c0), k_k = *(const f32x4*)(L.k_k + c0), k_a = *(const f32x4*)(L.k_a + c0), r_k = *(const f32x4*)(L.r_k + c0);
        float ev[4], kp[4];
#pragma unroll
        for (int r = 0; r < 4; ++r) {
            const float wv = -(w0[r] + accw[r]);
            const float sp = fmaxf(wv, 0.f) + __logf(1.0f + __expf(-fabsf(wv)));
            ev[r] = __expf(-sp - 0.5f);
            const float a = fsigmoid(a0[r] + acca[r]); av[ct][r] = a;
            const float kk_ = ks[r] * k_k[r]; kkv[ct][r] = kk_; ssq += kk_ * kk_;
            kp[r] = ks[r] * (1.0f + (a - 1.0f) * k_a[r]); rkp += rs[r] * kp[r] * r_k[r];
        }
        *(u32x2*)(ops + 2 * 64 + cl) = pack4(ev[0], ev[1], ev[2], ev[3]);
        *(u32x2*)(ops + 3 * 64 + cl) = pack4(kp[0], kp[1], kp[2], kp[3]);
        *(u32x2*)(ops + 4 * 64 + cl) = pack4(rs[0], rs[1], rs[2], rs[3]);
        *(u32x2*)(ops + 5 * 64 + cl) = pack4(vs[0], vs[1], vs[2], vs[3]);
        *(u32x2*)(MIXCAT + (size_t)tok * DM + c0) = pack4(accg[0], accg[1], accg[2], accg[3]);
    }
    ssq += __shfl_xor(ssq, 16); ssq += __shfl_xor(ssq, 32); rkp += __shfl_xor(rkp, 16); rkp += __shfl_xor(rkp, 32);
    const float inv = 1.0f / fmaxf(sqrtf(ssq), 1e-12f);
    if (fq == 0) RK[(size_t)tok * 8 + h] = rkp;
#pragma unroll
    for (int ct = 0; ct < 4; ++ct) { const int cl = 16 * ct + 4 * fq; float kap[4], bb[4];
#pragma unroll
        for (int r = 0; r < 4; ++r) { kap[r] = kkv[ct][r] * inv; bb[r] = kap[r] * av[ct][r]; }
        *(u32x2*)(ops + 0 * 64 + cl) = pack4(kap[0], kap[1], kap[2], kap[3]);
        *(u32x2*)(ops + 1 * 64 + cl) = pack4(bb[0], bb[1], bb[2], bb[3]); }
}
__device__ __forceinline__ void kbar_task(const bf16_t* QKV, float* KBAR, int task, int lane) {
    const int b = task / 48, j = (task / 6) % 8, h = task % 6;
    const bf16_t* p = QKV + ((size_t)b * SEQ + j * 256) * 1152 + 384 + h * 64 + lane; float acc = 0.f;
#pragma unroll 8
    for (int k = 0; k < 256; ++k) acc += bf2f(p[(size_t)k * 1152]);
    KBAR[((b * NH + h) * 8 + j) * 64 + lane] = acc * (1.0f / 256.0f);
}
__device__ __forceinline__ void gmlp_task(const Lay& L, const bf16_t* GM, bf16_t* MIXCAT, int task, LAS unsigned char* lds, int wave, int lane) {
    LAS bf16_t* vnT = (LAS bf16_t*)lds; constexpr int VP = 136;
    const int tok0 = task * 128;
    const f32x4 lg = *(const f32x4*)(L.gln_g + 4 * lane), lb = *(const f32x4*)(L.gln_b + 4 * lane);
    for (int i = 0; i < 16; ++i) { const int sl = wave * 16 + i; float v[4]; unpack4(*(const u32x2*)(GM + (size_t)(tok0 + sl) * 512 + 256 + 4 * lane), v);
#pragma unroll
        for (int r = 0; r < 4; ++r) v[r] = fgelu(v[r]);
        const float mean = wave_sum((v[0] + v[1]) + (v[2] + v[3])) * (1.0f / 256.0f);
        float q = 0.f;
#pragma unroll
        for (int r = 0; r < 4; ++r) { v[r] -= mean; q += v[r] * v[r]; }
        const float rstd = rsqrtf(wave_sum(q) * (1.0f / 256.0f) + 1e-6f);
        const unsigned p01 = cvt_pk_bf16(v[0] * rstd * lg.x + lb.x, v[1] * rstd * lg.y + lb.y), p23 = cvt_pk_bf16(v[2] * rstd * lg.z + lb.z, v[3] * rstd * lg.w + lb.w);
        vnT[(4 * lane + 0) * VP + sl] = (bf16_t)(p01 & 0xffff); vnT[(4 * lane + 1) * VP + sl] = (bf16_t)(p01 >> 16);
        vnT[(4 * lane + 2) * VP + sl] = (bf16_t)(p23 & 0xffff); vnT[(4 * lane + 3) * VP + sl] = (bf16_t)(p23 >> 16); }
    __syncthreads();
    const int fr = lane & 15, fq = lane >> 4, t = wave * 16 + fr, nkk = (wave * 16 + 15) / 32 + 1;
    for (int g = 0; g < 4; ++g) {
        bf16x8 Wf[4];
#pragma unroll
        for (int kk = 0; kk < 4; ++kk) { float w8[8];
            if (kk < nkk) { const float* wp = L.gw_s + ((size_t)g * 128 + t) * 128 + 32 * kk + 8 * fq; const f32x4 w0 = *(const f32x4*)wp, w1 = *(const f32x4*)(wp + 4);
                const float ww[8] = {w0.x, w0.y, w0.z, w0.w, w1.x, w1.y, w1.z, w1.w};
#pragma unroll
                for (int i = 0; i < 8; ++i) w8[i] = (32 * kk + 8 * fq + i <= t) ? ww[i] : 0.f;
            } else {
#pragma unroll
                for (int i = 0; i < 8; ++i) w8[i] = 0.f; }
            Wf[kk] = pack8(w8); }
        const float bs = L.gb_s[g * 128 + t];
#pragma unroll
        for (int ct = 0; ct < 4; ++ct) {
            f32x4 acc = {0.f, 0.f, 0.f, 0.f};
#pragma unroll
            for (int kk = 0; kk < 4; ++kk) if (kk < nkk)
                acc = __builtin_amdgcn_mfma_f32_16x16x32_bf16(*(const LAS bf16x8*)(vnT + (64 * g + 16 * ct + fr) * VP + 32 * kk + 8 * fq), Wf[kk], acc, 0, 0, 0);
            const int ch = 64 * g + 16 * ct + 4 * fq; float u[4]; unpack4(*(const u32x2*)(GM + (size_t)(tok0 + t) * 512 + ch), u);
            *(u32x2*)(MIXCAT + (size_t)(tok0 + t) * DM + 768 + ch) = pack4(fgelu(u[0]) * (acc[0] + bs), fgelu(u[1]) * (acc[1] + bs), fgelu(u[2]) * (acc[2] + bs), fgelu(u[3]) * (acc[3] + bs));
        }
    }
    __syncthreads();
}

__device__ __forceinline__ void scan_unit(const bf16_t* ops, float* Y, int b, int h, int row, int lane, LAS float* sl) {
    const int cg = lane & 15;
    float S0 = 0.f, S1 = 0.f, S2 = 0.f, S3 = 0.f, ykeep = 0.f;
    const u32x4* gsrc = (const u32x4*)ops; u32x4 pf[6];
#pragma unroll
    for (int k = 0; k < 6; ++k) pf[k] = gsrc[lane + 64 * k];
    for (int t0 = 0; t0 < SEQ; t0 += 8) {
#pragma unroll
        for (int k = 0; k < 6; ++k) { const int u = lane + 64 * k, tt = u / 48, rem = u % 48, vec = rem >> 3, ch0 = (rem & 7) * 8; float f[8]; unpack8(pf[k], f);
            if (vec == 2) {
#pragma unroll
                for (int i = 0; i < 8; ++i) f[i] = __expf(-f[i]); }
            LAS f32x4* d = (LAS f32x4*)(sl + tt * 384 + vec * 64 + ch0); d[0] = (f32x4){f[0], f[1], f[2], f[3]}; d[1] = (f32x4){f[4], f[5], f[6], f[7]}; }
        if (t0 + 8 < SEQ) {
#pragma unroll
            for (int k = 0; k < 6; ++k) pf[k] = gsrc[(size_t)(t0 / 8 + 1) * 384 + lane + 64 * k]; }
        LDS_WAIT();
#pragma unroll
        for (int tt = 0; tt < 8; ++tt) {
            const LAS float* p = sl + tt * 384;
            const f32x4 kap = *(const LAS f32x4*)(p + 4 * cg), bb = *(const LAS f32x4*)(p + 64 + 4 * cg), w4 = *(const LAS f32x4*)(p + 128 + 4 * cg),
                        k4 = *(const LAS f32x4*)(p + 192 + 4 * cg), r4 = *(const LAS f32x4*)(p + 256 + 4 * cg); const float v = p[320 + row];
            const float sa = -ar16((kap.x * S0 + kap.y * S1) + (kap.z * S2 + kap.w * S3));
            S0 = S0 * w4.x + (sa * bb.x + v * k4.x); S1 = S1 * w4.y + (sa * bb.y + v * k4.y); S2 = S2 * w4.z + (sa * bb.z + v * k4.z); S3 = S3 * w4.w + (sa * bb.w + v * k4.w);
            const float y = ar16((r4.x * S0 + r4.y * S1) + (r4.z * S2 + r4.w * S3));
            const int t = t0 + tt;
            if ((t & 15) == cg) ykeep = y;
            if ((t & 15) == 15) Y[((size_t)b * SEQ + (t - 15) + cg) * 384 + h * 64 + row] = ykeep;
        }
        LDS_WAIT();
    }
}
__device__ __forceinline__ void moba_task(const bf16_t* QKV, const float* KBAR, bf16_t* MIXCAT, int task, int lane, LAS unsigned char* vl) {
    const int fr = lane & 15, fq = lane >> 4;
    const int qb = 7 - task / 768; int rem = task % 768; const int b = rem / 96; rem %= 96; const int h = rem / 16, qg = rem % 16;
    const int q0 = qb * 256 + qg * 16, qpos = q0 + fr;
    const bf16_t* base = QKV + (size_t)b * SEQ * 1152;
    const bf16_t* qrow = base + (size_t)qpos * 1152 + h * 64;
    bf16x8 Qf[2]; Qf[0] = *(const bf16x8*)(qrow + 8 * fq); Qf[1] = *(const bf16x8*)(qrow + 32 + 8 * fq);
    float qv[16]; unpack8(__builtin_bit_cast(u32x4, Qf[0]), qv); unpack8(__builtin_bit_cast(u32x4, Qf[1]), qv + 8);
    float sc[7];
#pragma unroll
    for (int j = 0; j < 7; ++j) { sc[j] = -INFINITY;
        if (j < qb) { const float* kb = KBAR + ((b * NH + h) * 8 + j) * 64; const f32x4 k0 = *(const f32x4*)(kb + 8 * fq), k1 = *(const f32x4*)(kb + 8 * fq + 4), k2 = *(const f32x4*)(kb + 32 + 8 * fq), k3 = *(const f32x4*)(kb + 36 + 8 * fq);
            float s = qv[0] * k0.x + qv[1] * k0.y + qv[2] * k0.z + qv[3] * k0.w + qv[4] * k1.x + qv[5] * k1.y + qv[6] * k1.z + qv[7] * k1.w
                    + qv[8] * k2.x + qv[9] * k2.y + qv[10] * k2.z + qv[11] * k2.w + qv[12] * k3.x + qv[13] * k3.y + qv[14] * k3.z + qv[15] * k3.w;
            s += __shfl_xor(s, 16); s += __shfl_xor(s, 32); sc[j] = s; } }
    unsigned selmask = 0;
#pragma unroll
    for (int j = 0; j < 7; ++j) { int rank = 0;
#pragma unroll
        for (int i = 0; i < 7; ++i) if (i != j) rank += (i < qb) && (sc[i] > sc[j] || (sc[i] == sc[j] && i < j));
        if (j < qb && rank < 3) selmask |= 1u << j; }
    float m = -1e30f, l = 0.f; f32x4 O[4];
#pragma unroll
    for (int d = 0; d < 4; ++d) O[d] = (f32x4){0.f, 0.f, 0.f, 0.f};
    for (int j = 0; j <= qb; ++j) {
        const bool own = (j == qb);
        const bool rowsel = own || ((selmask >> j) & 1u);
        if (!own && __ballot(rowsel) == 0ull) continue;
        const int nsteps = own ? (qg * 16 + 15) / 32 + 1 : 8;
        for (int st = 0; st < nsteps; ++st) {
            const int key0 = j * 256 + st * 32;
#pragma unroll
            for (int k = 0; k < 4; ++k) { const int u = lane + 64 * k, key = u >> 3, d0 = (u & 7) * 8;
                *(LAS u32x4*)(vl + key * 144 + d0 * 2) = *(const u32x4*)(base + (size_t)(key0 + key) * 1152 + 768 + h * 64 + d0); }
            f32x4 sv[2];
#pragma unroll
            for (int kt = 0; kt < 2; ++kt) { const bf16_t* krow = base + (size_t)(key0 + 16 * kt + fr) * 1152 + 384 + h * 64; f32x4 a = {0.f, 0.f, 0.f, 0.f};
                a = __builtin_amdgcn_mfma_f32_16x16x32_bf16(*(const bf16x8*)(krow + 8 * fq), Qf[0], a, 0, 0, 0);
                a = __builtin_amdgcn_mfma_f32_16x16x32_bf16(*(const bf16x8*)(krow + 32 + 8 * fq), Qf[1], a, 0, 0, 0); sv[kt] = a; }
            float pv[8]; float mx = -INFINITY;
#pragma unroll
            for (int kt = 0; kt < 2; ++kt)
#pragma unroll
                for (int r = 0; r < 4; ++r) { const int kp = key0 + 16 * kt + 4 * fq + r; const bool ok = rowsel && (!own || kp <= qpos);
                    const float x = ok ? sv[kt][r] * 0.125f : -INFINITY; pv[kt * 4 + r] = x; mx = fmaxf(mx, x); }
            mx = fmaxf(mx, __shfl_xor(mx, 16)); mx = fmaxf(mx, __shfl_xor(mx, 32));
            const float mnew = fmaxf(m, mx), alpha = __expf(m - mnew); m = mnew;
            float ps = 0.f;
#pragma unroll
            for (int i = 0; i < 8; ++i) { pv[i] = __expf(pv[i] - mnew); ps += pv[i]; }
            l = l * alpha + ps;
#pragma unroll
            for (int d = 0; d < 4; ++d) O[d] = O[d] * alpha;
            const bf16x8 Pf = pack8(pv);
            LDS_WAIT();
#pragma unroll
            for (int d = 0; d < 4; ++d) { const LAS bf16_t* vp = (const LAS bf16_t*)(vl + (16 * d + fr) * 2); u32x4 w;
                w.x = (unsigned)vp[(4 * fq + 0) * 72] | ((unsigned)vp[(4 * fq + 1) * 72] << 16); w.y = (unsigned)vp[(4 * fq + 2) * 72] | ((unsigned)vp[(4 * fq + 3) * 72] << 16);
                w.z = (unsigned)vp[(16 + 4 * fq + 0) * 72] | ((unsigned)vp[(16 + 4 * fq + 1) * 72] << 16); w.w = (unsigned)vp[(16 + 4 * fq + 2) * 72] | ((unsigned)vp[(16 + 4 * fq + 3) * 72] << 16);
                O[d] = __builtin_amdgcn_mfma_f32_16x16x32_bf16(__builtin_bit_cast(bf16x8, w), Pf, O[d], 0, 0, 0); }
            LDS_WAIT();
        }
    }
    l += __shfl_xor(l, 16); l += __shfl_xor(l, 32); const float inv = 1.0f / l;
    bf16_t* orow = MIXCAT + ((size_t)b * SEQ + qpos) * DM + 384 + h * 64 + 4 * fq;
#pragma unroll
    for (int d = 0; d < 4; ++d) *(u32x2*)(orow + 16 * d) = pack4(O[d][0] * inv, O[d][1] * inv, O[d][2] * inv, O[d][3] * inv);
}
__device__ __forceinline__ void rwkv_post(const Lay& L, const float* Y, const bf16_t* OPS, const float* RK, bf16_t* MIXCAT, int gw, int ngw, int lane) {
    const int cg = lane & 15, sub = lane >> 4;
    for (int it = gw; it < MTOK * NH / 4; it += ngw) {
        const int pr = it * 4 + sub, tok = pr / NH, h = pr % NH, c0 = 64 * h + 4 * cg;
        const f32x4 y = *(const f32x4*)(Y + (size_t)tok * 384 + c0);
        const float mean = ar16((y.x + y.y) + (y.z + y.w)) * (1.0f / 64.0f);
        const f32x4 d = y - mean; const float var = ar16((d.x * d.x + d.y * d.y) + (d.z * d.z + d.w * d.w)) * (1.0f / 64.0f);
        const float rstd = rsqrtf(var + 64e-5f), rk = RK[(size_t)tok * 8 + h];
        const int bh = (tok >> 11) * NH + h, s = tok & (SEQ - 1);
        float v[4], g[4]; unpack4(*(const u32x2*)(OPS + ((size_t)bh * SEQ + s) * 384 + 5 * 64 + 4 * cg), v);
        bf16_t* mp = MIXCAT + (size_t)tok * DM + c0; unpack4(*(const u32x2*)mp, g);
        const f32x4 lg = *(const f32x4*)(L.lnx_g + c0), lb = *(const f32x4*)(L.lnx_b + c0);
        *(u32x2*)mp = pack4((d.x * rstd * lg.x + lb.x + rk * v[0]) * g[0], (d.y * rstd * lg.y + lb.y + rk * v[1]) * g[1], (d.z * rstd * lg.z + lb.z + rk * v[2]) * g[2], (d.w * rstd * lg.w + lb.w + rk * v[3]) * g[3]);
    }
}
__device__ __forceinline__ int grab(unsigned* ctr) { int t = 0; if ((threadIdx.x & 63) == 0) t = (int)atomicAdd(ctr, 1u); return __builtin_amdgcn_readfirstlane(t); }

typedef const __attribute__((address_space(4))) Params* KP;
__device__ __forceinline__ KP kargs() { KP p = (KP)__builtin_amdgcn_kernarg_segment_ptr(); asm volatile("" : "+s"(p)); return p; }
__device__ __forceinline__ int otid() { int t = threadIdx.x; asm volatile("" : "+v"(t)); return t; }
__device__ __forceinline__ Lay make_lay(KP kp, int l) {
    Lay L; unsigned char* ws = kp->ws; const unsigned char* wl = ws + WS_W + (size_t)l * WL_SIZE;
    L.mu = kp->in[3] + l * 1408; L.w0 = kp->in[4] + l * 384; L.a0 = kp->in[6] + l * 384; L.k_k = kp->in[9] + l * 384; L.k_a = kp->in[10] + l * 384; L.r_k = kp->in[11] + l * 384;
    L.lnx_g = kp->in[12] + l * 384; L.lnx_b = kp->in[13] + l * 384; L.gln_g = kp->in[14] + l * 256; L.gln_b = kp->in[15] + l * 256; L.gw_s = kp->in[16] + (size_t)l * 4 * 128 * 128; L.gb_s = kp->in[17] + l * 512;
    L.w2T = (const bf16_t*)(wl + WL_W2); L.a2T = (const bf16_t*)(wl + WL_A2); L.g2T = (const bf16_t*)(wl + WL_G2); return L;
}
#define PHASE_IDS() const int tid = otid(), lane = tid & 63, wave = __builtin_amdgcn_readfirstlane(tid >> 6), bid = blockIdx.x, G = gridDim.x, gw = bid * 8 + wave, ngw = G * 8; (void)lane; (void)wave; (void)gw; (void)ngw; (void)G
__global__ void __launch_bounds__(512, 2) fwd_megakernel(Params Pdummy) {
    extern __shared__ __attribute__((aligned(16))) unsigned char lds_raw[];
    cg::grid_group grid = cg::this_grid();
    LAS unsigned char* lds = (LAS unsigned char*)lds_raw;

    { KP kp = kargs(); PHASE_IDS();
      p0_weights(kp->in[2], kp->in[18], kp->in[21], kp->in[22], kp->in[5], kp->in[7], kp->in[8], kp->ws, lds, gw, ngw, wave, lane);
      row_phase(kp->in[0], nullptr, nullptr, nullptr, kp->in[1], (bf16_t*)(kp->ws + WS_XB), gw, ngw, lane); }
    grid.sync();

#pragma unroll 1
    for (int l = 0; l < NLAYER; ++l) {
        { KP kp = kargs(); unsigned char* ws = kp->ws; const unsigned char* wl = ws + WS_W + (size_t)l * WL_SIZE;
          pg8::Gemm g{(const bf16_t*)(ws + WS_XB), (const bf16_t*)(wl + WL_IN), MTOK, 3072, 1024}; pg8::StaticOrder S; S.init(MTOK, 3072, gridDim.x, blockIdx.x);
          pg8::EpiProj E{(bf16_t*)(ws + WS_RW), (bf16_t*)(ws + WS_QKV), (bf16_t*)(ws + WS_GM)};
          pg8::gemm_phase<pg8::EpiProj, pg8::StaticOrder, false>(lds, g, S, E, nullptr); }
        grid.sync();
        { KP kp = kargs(); PHASE_IDS(); unsigned char* ws = kp->ws; const Lay L = make_lay(kp, l);
          bf16_t* MIXCAT = (bf16_t*)(ws + WS_MIXCAT);
          if (bid < 128) gmlp_task(L, (const bf16_t*)(ws + WS_GM), MIXCAT, bid, lds, wave, lane);
          unsigned* ctr = (unsigned*)(ws + WS_CTL) + 64 * (2 * l);
          for (;;) { const int t = grab(ctr); if (t >= 384 + 6144) break;
              if (t < 384) kbar_task((const bf16_t*)(ws + WS_QKV), (float*)(ws + WS_KBAR), t, lane);
              else rwkv_prep_task(L, (const bf16_t*)(ws + WS_RW), (bf16_t*)(ws + WS_OPS), MIXCAT, (float*)(ws + WS_RK), t - 384, lane); } }
        grid.sync();
        { KP kp = kargs(); PHASE_IDS(); unsigned char* ws = kp->ws;
          if (bid < 192 && wave < 4) { const int xcd = bid & 7, k = bid >> 3, bh = xcd * 6 + (k >> 2), rg = k & 3;
              __builtin_amdgcn_s_setprio(3);
              scan_unit((const bf16_t*)(ws + WS_OPS) + (size_t)bh * SEQ * 384, (float*)(ws + WS_Y), bh / NH, bh % NH, 16 * rg + 4 * wave + (lane >> 4), lane, (LAS float*)(lds + 36864 + wave * 12288));
              __builtin_amdgcn_s_setprio(0); }
          unsigned* ctr = (unsigned*)(ws + WS_CTL) + 64 * (2 * l + 1);
          for (;;) { const int t = grab(ctr); if (t >= 6144) break; moba_task((const bf16_t*)(ws + WS_QKV), (const float*)(ws + WS_KBAR), (bf16_t*)(ws + WS_MIXCAT), t, lane, lds + wave * 4608); } }
        grid.sync();
        { KP kp = kargs(); PHASE_IDS(); unsigned char* ws = kp->ws; const Lay L = make_lay(kp, l);
          rwkv_post(L, (const float*)(ws + WS_Y), (const bf16_t*)(ws + WS_OPS), (const float*)(ws + WS_RK), (bf16_t*)(ws + WS_MIXCAT), gw, ngw, lane); }
        grid.sync();
        { KP kp = kargs(); unsigned char* ws = kp->ws; const unsigned char* wl = ws + WS_W + (size_t)l * WL_SIZE;
          pg8::Gemm g{(const bf16_t*)(ws + WS_MIXCAT), (const bf16_t*)(wl + WL_OUT), MTOK, 1024, 1024}; pg8::StaticOrder S; S.init(MTOK, 1024, gridDim.x, blockIdx.x); pg8::EpiF32 E{(float*)(ws + WS_MIXO), 1024};
          pg8::gemm_phase<pg8::EpiF32, pg8::StaticOrder, false>(lds, g, S, E, nullptr); }
        grid.sync();
        { KP kp = kargs(); PHASE_IDS(); unsigned char* ws = kp->ws;
          row_phase(l == 0 ? kp->in[0] : (const float*)kp->out, (const float*)(ws + WS_MIXO), kp->in[19] + l * DM, kp->out, kp->in[20] + l * DM, (bf16_t*)(ws + WS_XA), gw, ngw, lane); }
        grid.sync();
        { KP kp = kargs(); unsigned char* ws = kp->ws; const unsigned char* wl = ws + WS_W + (size_t)l * WL_SIZE;
          pg8::Gemm g{(const bf16_t*)(ws + WS_XA), (const bf16_t*)(wl + WL_FF), MTOK, 5632, 1024}; pg8::StaticOrder S; S.init(MTOK, 5632, gridDim.x, blockIdx.x); pg8::EpiSwiglu E{(bf16_t*)(ws + WS_FF)};
          pg8::gemm_phase<pg8::EpiSwiglu, pg8::StaticOrder, false>(lds, g, S, E, nullptr); }
        grid.sync();
        { KP kp = kargs(); unsigned char* ws = kp->ws; const unsigned char* wl = ws + WS_W + (size_t)l * WL_SIZE;
          pg8::Gemm g{(const bf16_t*)(ws + WS_FF), (const bf16_t*)(wl + WL_FF2), MTOK, 1024, DFF}; pg8::StaticOrder S; S.init(MTOK, 1024, gridDim.x, blockIdx.x); pg8::EpiF32 E{(float*)(ws + WS_MIXO2), 1024};
          pg8::gemm_phase<pg8::EpiF32, pg8::StaticOrder, false>(lds, g, S, E, nullptr); }
        grid.sync();
        { KP kp = kargs(); PHASE_IDS(); unsigned char* ws = kp->ws;
          row_phase((const float*)kp->out, (const float*)(ws + WS_MIXO2), kp->in[23] + l * DM, kp->out, l + 1 < NLAYER ? kp->in[1] + (l + 1) * DM : nullptr, l + 1 < NLAYER ? (bf16_t*)(ws + WS_XB) : nullptr, gw, ngw, lane); }
        if (l + 1 < NLAYER) grid.sync();
    }
}

extern "C" void kernel_launch(void* const* d_in, const int* in_sizes, int n_in, void* d_out, int out_size, void* d_ws, size_t ws_size, hipStream_t stream) {
    static int grid_blocks = 0;
    if (!grid_blocks) {
        int dev = 0, cus = 0, per_cu = 0;
        (void)hipGetDevice(&dev); (void)hipDeviceGetAttribute(&cus, hipDeviceAttributeMultiprocessorCount, dev);
        (void)hipFuncSetAttribute((const void*)fwd_megakernel, hipFuncAttributeMaxDynamicSharedMemorySize, LDS_BYTES);
        (void)hipOccupancyMaxActiveBlocksPerMultiprocessor(&per_cu, (const void*)fwd_megakernel, 512, LDS_BYTES);
        if (per_cu < 1) { fprintf(stderr, "kernel_launch: occupancy query says %d blocks per CU\n", per_cu); per_cu = 1; }
        grid_blocks = cus;
        if (ws_size < WS_END) fprintf(stderr, "kernel_launch: workspace too small: %zu < %zu\n", ws_size, (size_t)WS_END);
    }
    (void)hipMemsetAsync((unsigned char*)d_ws + WS_CTL, 0, 4096, stream);
    Params p{};
    for (int i = 0; i < 24; ++i) p.in[i] = (const float*)d_in[i];
    p.out = (float*)d_out; p.ws = (unsigned char*)d_ws;
    void* args[] = {&p};
    hipError_t e = hipLaunchCooperativeKernel((const void*)fwd_megakernel, dim3(grid_blocks), dim3(512), args, LDS_BYTES, stream);
    if (e != hipSuccess) fprintf(stderr, "cooperative launch failed: %s (grid %d)\n", hipGetErrorString(e), grid_blocks);
}
```

```cpp
#include <hip/hip_runtime.h>
#include <hip/hip_cooperative_groups.h>
#include <cstdio>
namespace cg = cooperative_groups;
#ifndef REP_P2
#define REP_P2 1
#endif
#ifndef REP_P3
#define REP_P3 1
#endif
namespace pg8 {
#define PG8_LAS __attribute__((address_space(3)))
typedef unsigned short bf16_t;
typedef short bf16x8 __attribute__((ext_vector_type(8)));
typedef float f32x4 __attribute__((ext_vector_type(4)));
typedef unsigned u32x4 __attribute__((ext_vector_type(4)));
constexpr int BM = 256, BK = 64, HALF = 128, HTB = HALF * BK * 2  , STAGE_BYTES = 8 * HTB, NXCD = 8, WGM = 8;

__host__ __device__ __forceinline__ int lds_byte(int r, int c) { const int st = (r >> 4) * 2 + (c >> 5), rr = r & 15, cc = c & 31, ob = rr * 64 + cc * 2; return st * 1024 + (ob ^ (((ob >> 9) & 1) << 5)); }
__host__ __device__ __forceinline__ void stage_rc(int b, int& R, int& C) { const int st = b / 1024, sb = b % 1024, swz = sb ^ (((sb >> 9) & 1) << 5); R = (st >> 1) * 16 + swz / 64; C = (st & 1) * 32 + (swz % 64) / 2; }
__host__ __device__ __forceinline__ int perm32(int rho) { const int n = rho >> 4, i = rho & 15; return 8 * (i >> 2) + 4 * n + (i & 3); }

struct Unit { int pm, pn; };
struct Gemm { const bf16_t* A; const bf16_t* Bt; int M, N, K; };

struct StaticOrder {
    int nM, nN, nwg, G, c;
    __host__ __device__ void init(int M, int N, int G_, int c_) { nM = M / BM; nN = N / BM; nwg = nM * nN; G = G_; c = c_; }
    __host__ __device__ bool next(int i, Unit& u) const {
        const long L = (long)i * G + c; if (L >= nwg) return false;
        int wgid = (int)L; { const int q = nwg / NXCD, r = nwg % NXCD, xcd = wgid % NXCD, off = wgid / NXCD; wgid = (xcd < r ? xcd * (q + 1) : r * (q + 1) + (xcd - r) * q) + off; }
        const int nig = WGM * nN, gid = wgid / nig, fm = gid * WGM, gsz = (nM - fm) < WGM ? (nM - fm) : WGM;
        u.pm = fm + ((wgid % nig) % gsz); u.pn = (wgid % nig) / gsz; return true;
    }
    __device__ __forceinline__ void a_ready(const Unit&) const {}
    __device__ __forceinline__ void done(const Unit&) const {}
};
__device__ __forceinline__ unsigned cvt_pk_bf16(float lo, float hi) { unsigned r; asm volatile("v_cvt_pk_bf16_f32 %0, %1, %2" : "=v"(r) : "v"(lo), "v"(hi)); return r; }
typedef float f32x2 __attribute__((ext_vector_type(2)));
struct EpiF32 {
    static constexpr bool PERM = false, AFTER_DRAIN = false;
    float* C; int ldc;
    __device__ __forceinline__ void operator()(const f32x4 (&acc)[2][2][4][2], const Unit& u, int wr, int wc, int fr, int fq) const {
        const int row0 = u.pm * BM + wr * 64 + fr, col0 = u.pn * BM + wc * 32 + 4 * fq;
#pragma unroll
        for (int ai = 0; ai < 2; ++ai)
#pragma unroll
            for (int m = 0; m < 4; ++m) { float* rowp = C + (size_t)(row0 + ai * HALF + m * 16) * ldc + col0;
#pragma unroll
                for (int bj = 0; bj < 2; ++bj)
#pragma unroll
                    for (int n = 0; n < 2; ++n) *(f32x4*)(rowp + bj * HALF + n * 16) = acc[ai][bj][m][n]; }
    }
};
struct EpiProj {
    static constexpr bool PERM = true, AFTER_DRAIN = false;
    bf16_t *RW, *QKV, *GM;
    __device__ __forceinline__ void operator()(const f32x4 (&acc)[2][2][4][2], const Unit& u, int wr, int wc, int fr, int fq) const {
        const int row0 = u.pm * BM + wr * 64 + fr;
#pragma unroll
        for (int bj = 0; bj < 2; ++bj) {
            const int hh = 2 * u.pn + bj; bf16_t* base; int ld, c0;
            if (hh < 11) { base = RW; ld = 1408; c0 = 128 * hh; } else if (hh < 20) { base = QKV; ld = 1152; c0 = 128 * (hh - 11); } else { base = GM; ld = 512; c0 = 128 * (hh - 20); }
            const int col = c0 + wc * 32 + 8 * fq;
#pragma unroll
            for (int ai = 0; ai < 2; ++ai)
#pragma unroll
                for (int m = 0; m < 4; ++m) { const f32x4 v0 = acc[ai][bj][m][0], v1 = acc[ai][bj][m][1];
                    u32x4 w; w.x = cvt_pk_bf16(v0[0], v0[1]); w.y = cvt_pk_bf16(v0[2], v0[3]); w.z = cvt_pk_bf16(v1[0], v1[1]); w.w = cvt_pk_bf16(v1[2], v1[3]);
                    *(u32x4*)(base + (size_t)(row0 + ai * HALF + m * 16) * ld + col) = w; }
        }
    }
};
__device__ __forceinline__ float silu_mul(float g, float u) { return g * __builtin_amdgcn_rcpf(1.0f + __expf(-g)) * u; }
struct EpiSwiglu {
    static constexpr bool PERM = true, AFTER_DRAIN = false;
    bf16_t* FF;
    __device__ __forceinline__ void operator()(const f32x4 (&acc)[2][2][4][2], const Unit& u, int wr, int wc, int fr, int fq) const {
        const int row0 = u.pm * BM + wr * 64 + fr, col = 128 * u.pn + wc * 32 + 8 * fq;
#pragma unroll
        for (int ai = 0; ai < 2; ++ai)
#pragma unroll
            for (int m = 0; m < 4; ++m) { const f32x4 g0 = acc[ai][0][m][0], g1 = acc[ai][0][m][1], u0 = acc[ai][1][m][0], u1 = acc[ai][1][m][1];
                u32x4 w; w.x = cvt_pk_bf16(silu_mul(g0[0], u0[0]), silu_mul(g0[1], u0[1])); w.y = cvt_pk_bf16(silu_mul(g0[2], u0[2]), silu_mul(g0[3], u0[3]));
                w.z = cvt_pk_bf16(silu_mul(g1[0], u1[0]), silu_mul(g1[1], u1[1])); w.w = cvt_pk_bf16(silu_mul(g1[2], u1[2]), silu_mul(g1[3], u1[3]));
                *(u32x4*)(FF + (size_t)(row0 + ai * HALF + m * 16) * 2816 + col) = w; }
    }
};
template <class Epi, class Sched, bool STAMP = false>
__device__ __forceinline__ void gemm_phase(PG8_LAS unsigned char* lds, const Gemm g, const Sched& S, const Epi& E, unsigned long long* stamps) {
    int tid_ = threadIdx.x; asm volatile("" : "+v"(tid_));
    const int tid = tid_, wid = __builtin_amdgcn_readfirstlane(tid >> 6), lane = tid & 63, wr = wid >> 2, wc = wid & 3, fr = lane & 15, fq = lane >> 4;
    const int K = g.K, nt = K / BK;
    int ts_lo = 0, ts_hi = 0, nts = 0; const unsigned long long rt_entry = STAMP ? (unsigned long long)wall_clock64() : 0ull;
#define PG8_STAMP() do { if (STAMP && wid == 0 && nts < 64) { const unsigned long long _c = (unsigned long long)clock64(); \
        ts_lo = (lane == nts) ? (int)(unsigned)_c : ts_lo; ts_hi = (lane == nts) ? (int)(unsigned)(_c >> 32) : ts_hi; ++nts; } } while (0)
    PG8_STAMP();
    unsigned voffA[2], voffB[2];
#pragma unroll
    for (int i = 0; i < 2; ++i) { int R, C; stage_rc(tid * 16 + i * 8192, R, C); const int Rb = Epi::PERM ? ((R & ~31) + perm32(R & 31)) : R;
        voffA[i] = (unsigned)(R * K + C) * 2u; voffB[i] = (unsigned)(Rb * K + C) * 2u; }
    const size_t kstep = (size_t)(BK * 2);
    const size_t hstep = (size_t)HALF * K * 2;
    const size_t tstep = 2 * hstep;
    const unsigned ldsw = (unsigned)wid * 1024u;
    const int aoff = lds_byte(wr * 64 + fr, fq * 8), boff = lds_byte(wc * 32 + fr, fq * 8);
#define PG8_SA(b, h) (((b) * 2 + (h)) * HTB)
#define PG8_SB(b, h) ((4 + (b) * 2 + (h)) * HTB)
#define PG8_STAGE(bufoff, gbase, voff) do { _Pragma("unroll") for (int _i = 0; _i < 2; ++_i) \
        __builtin_amdgcn_global_load_lds((const unsigned*)((const char*)(gbase) + (voff)[_i]), (PG8_LAS unsigned*)(lds + (bufoff) + ldsw + _i * 8192), 16, 0, 0); } while (0)
#define PG8_LDA(dst, b, h) do { _Pragma("unroll") for (int m = 0; m < 4; ++m) _Pragma("unroll") for (int k = 0; k < 2; ++k) dst[m][k] = *(const PG8_LAS bf16x8*)(lds + PG8_SA(b, h) + aoff + m * 2048 + k * 1024); } while (0)
#define PG8_LDB(dst, b, h) do { _Pragma("unroll") for (int n = 0; n < 2; ++n) _Pragma("unroll") for (int k = 0; k < 2; ++k) dst[n][k] = *(const PG8_LAS bf16x8*)(lds + PG8_SB(b, h) + boff + n * 2048 + k * 1024); } while (0)
#define PG8_MMA(ai, bj, At, Bt) do { __builtin_amdgcn_s_setprio(1); _Pragma("unroll") for (int m = 0; m < 4; ++m) _Pragma("unroll") for (int n = 0; n < 2; ++n) _Pragma("unroll") for (int k = 0; k < 2; ++k) \
        acc[ai][bj][m][n] = __builtin_amdgcn_mfma_f32_16x16x32_bf16(Bt[n][k], At[m][k], acc[ai][bj][m][n], 0, 0, 0); __builtin_amdgcn_s_setprio(0); } while (0)
#define PG8_WAIT_V(n) asm volatile("s_waitcnt vmcnt(" #n ")" ::: "memory")
#define PG8_WAIT_L(n) asm volatile("s_waitcnt lgkmcnt(" #n ")" ::: "memory")
#define PG8_BAR __builtin_amdgcn_s_barrier()
#define PG8_SCHED __builtin_amdgcn_sched_barrier(0)
    Unit cur, nxt; int ui = 0;
    if (!S.next(0, cur)) return;
    f32x4 acc[2][2][4][2];
#pragma unroll
    for (int a = 0; a < 2; ++a)
#pragma unroll
        for (int b = 0; b < 2; ++b)
#pragma unroll
            for (int m = 0; m < 4; ++m)
#pragma unroll
                for (int n = 0; n < 2; ++n) acc[a][b][m][n] = (f32x4){0.f, 0.f, 0.f, 0.f};
    bf16x8 At[4][2], B0[2][2], B1[2][2];
    const char* cA = (const char*)g.A + (size_t)cur.pm * tstep; const char* cB = (const char*)g.Bt + (size_t)cur.pn * tstep;
    S.a_ready(cur);
    PG8_STAGE(PG8_SB(0, 0), cB, voffB); PG8_STAGE(PG8_SA(0, 0), cA, voffA); PG8_STAGE(PG8_SB(0, 1), cB + hstep, voffB); PG8_STAGE(PG8_SA(0, 1), cA + hstep, voffA);
    if (wr == 1) PG8_BAR;
    PG8_WAIT_V(4); PG8_BAR;
    PG8_STAGE(PG8_SB(1, 0), cB + kstep, voffB); PG8_STAGE(PG8_SA(1, 0), cA + kstep, voffA); PG8_STAGE(PG8_SB(1, 1), cB + hstep + kstep, voffB);
    PG8_WAIT_V(6); PG8_BAR;
    PG8_STAMP();
    for (;;) {
        const bool has_next = S.next(ui + 1, nxt);
        const char* nA = has_next ? (const char*)g.A + (size_t)nxt.pm * tstep : cA; const char* nB = has_next ? (const char*)g.Bt + (size_t)nxt.pn * tstep : cB;
        for (int t = 0; t < nt; t += 2) {
            const bool last = (t == nt - 2);
            const char* a1 = cA + (size_t)(t + 1) * kstep;
            const char* a2 = last ? nA : cA + (size_t)(t + 2) * kstep; const char* b2 = last ? nB : cB + (size_t)(t + 2) * kstep;
            const char* a3 = a2 + kstep; const char* b3 = b2 + kstep;
            if (last && has_next) S.a_ready(nxt);
            PG8_LDB(B0, 0, 0); PG8_SCHED; PG8_LDA(At, 0, 0); PG8_STAGE(PG8_SA(1, 1), a1 + hstep, voffA);
            PG8_WAIT_L(8); PG8_BAR; PG8_WAIT_L(0); PG8_MMA(0, 0, At, B0); PG8_BAR; PG8_SCHED;
            PG8_LDB(B1, 0, 1); PG8_STAGE(PG8_SB(0, 0), b2, voffB);
            PG8_BAR; PG8_WAIT_L(0); PG8_MMA(0, 1, At, B1); PG8_BAR;
            PG8_LDA(At, 0, 1); PG8_STAGE(PG8_SA(0, 0), a2, voffA);
            PG8_BAR; PG8_WAIT_L(0); PG8_MMA(1, 0, At, B0); PG8_BAR; PG8_SCHED;
            PG8_STAGE(PG8_SB(0, 1), b2 + hstep, voffB);
            PG8_WAIT_V(6); PG8_BAR; PG8_MMA(1, 1, At, B1); PG8_BAR;
            PG8_LDB(B0, 1, 0); PG8_SCHED; PG8_LDA(At, 1, 0); PG8_STAGE(PG8_SA(0, 1), a2 + hstep, voffA);
            PG8_WAIT_L(8); PG8_BAR; PG8_WAIT_L(0); PG8_MMA(0, 0, At, B0); PG8_BAR; PG8_SCHED;
            PG8_LDB(B1, 1, 1); PG8_STAGE(PG8_SB(1, 0), b3, voffB);
            PG8_BAR; PG8_WAIT_L(0); PG8_MMA(0, 1, At, B1); PG8_BAR;
            PG8_LDA(At, 1, 1); PG8_STAGE(PG8_SA(1, 0), a3, voffA);
            PG8_BAR; PG8_WAIT_L(0); PG8_MMA(1, 0, At, B0); PG8_BAR; PG8_SCHED;
            PG8_STAGE(PG8_SB(1, 1), b3 + hstep, voffB);
            PG8_WAIT_V(6); PG8_BAR; PG8_MMA(1, 1, At, B1); PG8_BAR;
        }
        PG8_STAMP();
        if constexpr (!Epi::AFTER_DRAIN) { E(acc, cur, wr, wc, fr, fq); S.done(cur); }
        PG8_STAMP();
        if (!has_next) break;
#pragma unroll
        for (int a = 0; a < 2; ++a)
#pragma unroll
            for (int b = 0; b < 2; ++b)
#pragma unroll
                for (int m = 0; m < 4; ++m)
#pragma unroll
                    for (int n = 0; n < 2; ++n) acc[a][b][m][n] = (f32x4){0.f, 0.f, 0.f, 0.f};
        cur = nxt; cA = nA; cB = nB; ++ui;
    }
    PG8_WAIT_V(0);
    if (wr == 0) PG8_BAR;
    PG8_BAR;
    if constexpr (Epi::AFTER_DRAIN) { E.fused(acc, cur, wr, wc, fr, fq, lds, wid, lane); S.done(cur); }
    PG8_STAMP();
    if (STAMP && wid == 0) { stamps[lane] = lane < nts ? (((unsigned long long)(unsigned)ts_hi << 32) | (unsigned)ts_lo) : 0ull;
        if (lane == 62) stamps[62] = rt_entry; if (lane == 63) stamps[63] = (unsigned long long)wall_clock64(); }
#undef PG8_STAMP
#undef PG8_SA
#undef PG8_SB
#undef PG8_STAGE
#undef PG8_LDA
#undef PG8_LDB
#undef PG8_MMA
#undef PG8_WAIT_V
#undef PG8_WAIT_L
#undef PG8_BAR
#undef PG8_SCHED
}
}
#define LAS __attribute__((address_space(3)))
typedef unsigned short bf16_t;
typedef short bf16x8 __attribute__((ext_vector_type(8)));
typedef float f32x4 __attribute__((ext_vector_type(4)));
typedef unsigned u32x4 __attribute__((ext_vector_type(4)));
typedef unsigned u32x2 __attribute__((ext_vector_type(2)));
using pg8::cvt_pk_bf16;
constexpr int MTOK = 16384, DM = 1024, SEQ = 2048, NB = 8, NH = 6, DFF = 2816, NLAYER = 2;
constexpr size_t MiB = 1u << 20;
constexpr size_t WS_CTL = 0, WS_KBAR = 65536, WS_RK = 262144, WS_W = 1 * MiB;
constexpr size_t WL_IN = 0, WL_OUT = WL_IN + 3072ull * 1024 * 2, WL_FF = WL_OUT + 1024ull * 1024 * 2, WL_FF2 = WL_FF + 5632ull * 1024 * 2, WL_W2 = WL_FF2 + 1024ull * 2816 * 2,
                 WL_A2 = WL_W2 + 384 * 64 * 2, WL_G2 = WL_A2 + 384 * 64 * 2, WL_SIZE = WL_G2 + 384 * 128 * 2;
static_assert(WS_W + 2 * WL_SIZE <= 52 * MiB, "weights region");
constexpr size_t WS_RW = 52 * MiB, WS_QKV = 96 * MiB, WS_GM = 132 * MiB, WS_U = 148 * MiB, WS_XB = 220 * MiB, WS_END = 252 * MiB;
constexpr size_t WS_Y = WS_RW, WS_MIXO = WS_RW, WS_FF = WS_RW, WS_XA = WS_U, WS_MIXO2 = WS_U + 8 * MiB, WS_OPS = WS_U, WS_MIXCAT = WS_XB;
constexpr int LDS_BYTES = 131072 + 64;
constexpr size_t WS_BAR = 4096;
constexpr int CTL_ZERO_BYTES = 4096 + 3456 * 4;

__device__ __forceinline__ float bf2f(bf16_t b) { return __uint_as_float(((unsigned)b) << 16); }
__device__ __forceinline__ float bflo(unsigned u) { return __uint_as_float(u << 16); }
__device__ __forceinline__ float bfhi(unsigned u) { return __uint_as_float(u & 0xffff0000u); }
__device__ __forceinline__ float wave_sum(float v) {
#pragma unroll
    for (int o = 1; o < 64; o <<= 1) v += __shfl_xor(v, o);
    return v;
}
template <int CTRL> __device__ __forceinline__ float dppf(float x) { return __int_as_float(__builtin_amdgcn_update_dpp(0, __float_as_int(x), CTRL, 0xF, 0xF, true)); }
__device__ __forceinline__ float ar16(float x) {
    x += dppf<0xB1>(x); x += dppf<0x4E>(x); x += dppf<0x141>(x); x += dppf<0x140>(x); return x;
}
__device__ __forceinline__ float fsigmoid(float x) { return 1.0f / (1.0f + __expf(-x)); }
__device__ __forceinline__ float ftanh(float x) { const float e = __expf(-2.0f * fabsf(x)); const float t = (1.0f - e) / (1.0f + e); return x < 0.f ? -t : t; }
__device__ __forceinline__ float fgelu(float x) { return 0.5f * x * (1.0f + ftanh(0.7978845608028654f * (x + 0.044715f * x * x * x))); }
__device__ __forceinline__ bf16x8 pack8(const float* f) { u32x4 w; w.x = cvt_pk_bf16(f[0], f[1]); w.y = cvt_pk_bf16(f[2], f[3]); w.z = cvt_pk_bf16(f[4], f[5]); w.w = cvt_pk_bf16(f[6], f[7]); return __builtin_bit_cast(bf16x8, w); }
__device__ __forceinline__ void unpack8(u32x4 w, float* f) { f[0] = bflo(w.x); f[1] = bfhi(w.x); f[2] = bflo(w.y); f[3] = bfhi(w.y); f[4] = bflo(w.z); f[5] = bfhi(w.z); f[6] = bflo(w.w); f[7] = bfhi(w.w); }
__device__ __forceinline__ void unpack4(u32x2 w, float* f) { f[0] = bflo(w.x); f[1] = bfhi(w.x); f[2] = bflo(w.y); f[3] = bfhi(w.y); }
__device__ __forceinline__ u32x2 pack4(float a, float b, float c, float d) { u32x2 w; w.x = cvt_pk_bf16(a, b); w.y = cvt_pk_bf16(c, d); return w; }
#define LDS_WAIT() asm volatile("s_waitcnt lgkmcnt(0)" ::: "memory")

struct Params { const float* in[24]; float* out; unsigned char* ws; };

__device__ __forceinline__ void transpose_item(const float* W, int K, int N, bf16_t* WT, int k0, int n0, int drow, LAS float* scr, int lane) {
#pragma unroll 8
    for (int i = 0; i < 32; ++i) { const int kk = 2 * i + (lane >> 5); scr[kk * 33 + (lane & 31)] = W[(size_t)(k0 + kk) * N + n0 + (lane & 31)]; }
    LDS_WAIT();
    const int c = lane & 7;
#pragma unroll
    for (int j = 0; j < 4; ++j) { const int n = (lane >> 3) + 8 * j; const LAS float* s = scr + (8 * c) * 33 + n;
        u32x4 o; o.x = cvt_pk_bf16(s[0 * 33], s[1 * 33]); o.y = cvt_pk_bf16(s[2 * 33], s[3 * 33]); o.z = cvt_pk_bf16(s[4 * 33], s[5 * 33]); o.w = cvt_pk_bf16(s[6 * 33], s[7 * 33]);
        *(u32x4*)(WT + (size_t)(drow + n) * K + k0 + 8 * c) = o; }
    LDS_WAIT();
}
__device__ __forceinline__ void transpose_mat(const float* W, int K, int N, bf16_t* WT, int item, bool swiglu, LAS float* scr, int lane) {
    const int nblk = N / 32, kb = item / nblk, nb = item % nblk, n0 = 32 * nb;
    int drow = n0;
    if (swiglu) { if (n0 < DFF) drow = 256 * (n0 / 128) + (n0 % 128); else { const int q = n0 - DFF; drow = 256 * (q / 128) + 128 + (q % 128); } }
    transpose_item(W, K, N, WT, 64 * kb, n0, drow, scr, lane);
}
__device__ __forceinline__ void p0_weights(const float* w_in, const float* w_out, const float* w_ffi, const float* w_ffo, const float* w2, const float* a2, const float* g2, unsigned char* ws, LAS unsigned char* lds, int gw, int ngw, int wave, int lane) {
    LAS float* scr = (LAS float*)(lds + wave * 8448);
    constexpr int I_IN = 16 * 96, I_OUT = 16 * 32, I_FF = 16 * 176, I_FF2 = 44 * 32, I_W2 = 12, I_A2 = 12, I_G2 = 24, I_L = I_IN + I_OUT + I_FF + I_FF2 + I_W2 + I_A2 + I_G2;
    for (int it = gw; it < NLAYER * I_L; it += ngw) {
        const int l = it / I_L; int r = it % I_L; unsigned char* wl = ws + WS_W + (size_t)l * WL_SIZE;
        if (r < I_IN) { transpose_mat(w_in + (size_t)l * 1024 * 3072, 1024, 3072, (bf16_t*)(wl + WL_IN), r, false, scr, lane); continue; } r -= I_IN;
        if (r < I_OUT) { transpose_mat(w_out + (size_t)l * 1024 * 1024, 1024, 1024, (bf16_t*)(wl + WL_OUT), r, false, scr, lane); continue; } r -= I_OUT;
        if (r < I_FF) { transpose_mat(w_ffi + (size_t)l * 1024 * 5632, 1024, 5632, (bf16_t*)(wl + WL_FF), r, true, scr, lane); continue; } r -= I_FF;
        if (r < I_FF2) { transpose_mat(w_ffo + (size_t)l * 2816 * 1024, 2816, 1024, (bf16_t*)(wl + WL_FF2), r, false, scr, lane); continue; } r -= I_FF2;
        if (r < I_W2) { transpose_mat(w2 + (size_t)l * 64 * 384, 64, 384, (bf16_t*)(wl + WL_W2), r, false, scr, lane); continue; } r -= I_W2;
        if (r < I_A2) { transpose_mat(a2 + (size_t)l * 64 * 384, 64, 384, (bf16_t*)(wl + WL_A2), r, false, scr, lane); continue; } r -= I_A2;
        transpose_mat(g2 + (size_t)l * 128 * 384, 128, 384, (bf16_t*)(wl + WL_G2), r, false, scr, lane);
    }
}
__device__ __forceinline__ void row_phase(const float* res, const float* add, const float* g_add, float* res_out, const float* g_xn, bf16_t* xn, int gw, int ngw, int lane) {
    for (int m = gw; m < MTOK; m += ngw) {
        const f32x4* xr = (const f32x4*)(res + (size_t)m * DM) + lane; f32x4 x[4];
#pragma unroll
        for (int j = 0; j < 4; ++j) x[j] = xr[64 * j];
        if (add) {
            const f32x4* ar = (const f32x4*)(add + (size_t)m * DM) + lane; f32x4 a[4]; float ss = 0.f;
#pragma unroll
            for (int j = 0; j < 4; ++j) { a[j] = ar[64 * j]; ss += (a[j].x * a[j].x + a[j].y * a[j].y) + (a[j].z * a[j].z + a[j].w * a[j].w); }
            const float rs = rsqrtf(wave_sum(ss) * (1.0f / DM) + 1e-6f);
            f32x4* orow = (f32x4*)(res_out + (size_t)m * DM) + lane;
#pragma unroll
            for (int j = 0; j < 4; ++j) { const f32x4 g = ((const f32x4*)g_add)[lane + 64 * j]; x[j] = x[j] + a[j] * rs * g; orow[64 * j] = x[j]; }
        }
        if (xn) {
            float ss = 0.f;
#pragma unroll
            for (int j = 0; j < 4; ++j) ss += (x[j].x * x[j].x + x[j].y * x[j].y) + (x[j].z * x[j].z + x[j].w * x[j].w);
            const float rs = rsqrtf(wave_sum(ss) * (1.0f / DM) + 1e-6f);
            u32x2* o8 = (u32x2*)(xn + (size_t)m * DM) + lane;
#pragma unroll
            for (int j = 0; j < 4; ++j) { const f32x4 g = ((const f32x4*)g_xn)[lane + 64 * j]; o8[64 * j] = pack4(x[j].x * rs * g.x, x[j].y * rs * g.y, x[j].z * rs * g.z, x[j].w * rs * g.w); }
        }
    }
}

struct Lay { const float *mu, *w0, *a0, *k_k, *k_a, *r_k, *lnx_g, *lnx_b, *gln_g, *gln_b, *gw_s, *gb_s; const bf16_t *w2T, *a2T, *g2T; };
__device__ __forceinline__ void shifted8(const bf16_t* row, bool hp, const float* mu, int col, float* o) {
    float c[8], p[8]; unpack8(*(const u32x4*)(row + col), c);
    if (hp) unpack8(*(const u32x4*)(row - 1408 + col), p); else {
#pragma unroll
        for (int i = 0; i < 8; ++i) p[i] = 0.f; }
    const f32x4 m0 = *(const f32x4*)(mu + col), m1 = *(const f32x4*)(mu + col + 4); const float mm[8] = {m0.x, m0.y, m0.z, m0.w, m1.x, m1.y, m1.z, m1.w};
#pragma unroll
    for (int i = 0; i < 8; ++i) o[i] = c[i] + mm[i] * (p[i] - c[i]);
}
__device__ __forceinline__ void shifted4(const bf16_t* row, bool hp, const float* mu, int col, float* o) {
    float c[4], p[4]; unpack4(*(const u32x2*)(row + col), c);
    if (hp) unpack4(*(const u32x2*)(row - 1408 + col), p); else { p[0] = p[1] = p[2] = p[3] = 0.f; }
    const f32x4 m0 = *(const f32x4*)(mu + col); const float mm[4] = {m0.x, m0.y, m0.z, m0.w};
#pragma unroll
    for (int i = 0; i < 4; ++i) o[i] = c[i] + mm[i] * (p[i] - c[i]);
}
__device__ __forceinline__ void rwkv_prep_task(const Lay& L, const bf16_t* RW, bf16_t* OPS, bf16_t* MIXCAT, float* RK, int task, int lane) {
    const int tg = task / NH, h = task % NH, fr = lane & 15, fq = lane >> 4;
    const int tok = tg * 16 + fr, s = tok & (SEQ - 1); const bool hp = s > 0;
    const bf16_t* row = RW + (size_t)tok * 1408;
    bf16x8 Aw[2], Aa[2], Ag[4]; float t8[8];
#pragma unroll
    for (int kk = 0; kk < 2; ++kk) { shifted8(row, hp, L.mu, 1152 + 32 * kk + 8 * fq, t8);
#pragma unroll
        for (int i = 0; i < 8; ++i) t8[i] = ftanh(t8[i]);
        Aw[kk] = pack8(t8); }
#pragma unroll
    for (int kk = 0; kk < 2; ++kk) { shifted8(row, hp, L.mu, 1216 + 32 * kk + 8 * fq, t8); Aa[kk] = pack8(t8); }
#pragma unroll
    for (int kk = 0; kk < 4; ++kk) { shifted8(row, hp, L.mu, 1280 + 32 * kk + 8 * fq, t8);
#pragma unroll
        for (int i = 0; i < 8; ++i) t8[i] = fsigmoid(t8[i]);
        Ag[kk] = pack8(t8); }
    const int bh = (tok >> 11) * NH + h;
    bf16_t* ops = OPS + ((size_t)bh * SEQ + s) * 384;
    float kkv[4][4], av[4][4]; float ssq = 0.f, rkp = 0.f;
#pragma unroll
    for (int ct = 0; ct < 4; ++ct) {
        const int wrow = 64 * h + 16 * ct + fr;
        f32x4 accw = {0.f, 0.f, 0.f, 0.f}, acca = {0.f, 0.f, 0.f, 0.f}, accg = {0.f, 0.f, 0.f, 0.f};
#pragma unroll
        for (int kk = 0; kk < 2; ++kk) {
            accw = __builtin_amdgcn_mfma_f32_16x16x32_bf16(*(const bf16x8*)(L.w2T + (size_t)wrow * 64 + 32 * kk + 8 * fq), Aw[kk], accw, 0, 0, 0);
            acca = __builtin_amdgcn_mfma_f32_16x16x32_bf16(*(const bf16x8*)(L.a2T + (size_t)wrow * 64 + 32 * kk + 8 * fq), Aa[kk], acca, 0, 0, 0); }
#pragma unroll
        for (int kk = 0; kk < 4; ++kk)
            accg = __builtin_amdgcn_mfma_f32_16x16x32_bf16(*(const bf16x8*)(L.g2T + (size_t)wrow * 128 + 32 * kk + 8 * fq), Ag[kk], accg, 0, 0, 0);
        const int cl = 16 * ct + 4 * fq, c0 = 64 * h + cl;
        float rs[4], ks[4], vs[4]; shifted4(row, hp, L.mu, c0, rs); shifted4(row, hp, L.mu, 384 + c0, ks); shifted4(row, hp, L.mu, 768 + c0, vs);
        const f32x4 w0 = *(const f32x4*)(L.w0 + c0), a0 = *(const f32x4*)(L.a0 + c0), k_k = *(const f32x4*)(L.k_k + c0), k_a = *(const f32x4*)(L.k_a + c0), r_k = *(const f32x4*)(L.r_k + c0);
        float ev[4], kp[4];
#pragma unroll
        for (int r = 0; r < 4; ++r) {
            const float wv = -(w0[r] + accw[r]);
            const float sp = fmaxf(wv, 0.f) + __logf(1.0f + __expf(-fabsf(wv)));
            ev[r] = 1.0f - __expf(-__expf(-sp - 0.5f));
            const float a = fsigmoid(a0[r] + acca[r]); av[ct][r] = a;
            const float kk_ = ks[r] * k_k[r]; kkv[ct][r] = kk_; ssq += kk_ * kk_;
            kp[r] = ks[r] * (1.0f + (a - 1.0f) * k_a[r]); rkp += rs[r] * kp[r] * r_k[r];
        }
        *(u32x2*)(ops + 2 * 64 + cl) = pack4(ev[0], ev[1], ev[2], ev[3]);
        *(u32x2*)(ops + 3 * 64 + cl) = pack4(kp[0], kp[1], kp[2], kp[3]);
        *(u32x2*)(ops + 4 * 64 + cl) = pack4(rs[0], rs[1], rs[2], rs[3]);
        *(u32x2*)(ops + 5 * 64 + cl) = pack4(vs[0], vs[1], vs[2], vs[3]);
        *(u32x2*)(MIXCAT + (size_t)tok * DM + c0) = pack4(accg[0], accg[1], accg[2], accg[3]);
    }
    ssq += __shfl_xor(ssq, 16); ssq += __shfl_xor(ssq, 32); rkp += __shfl_xor(rkp, 16); rkp += __shfl_xor(rkp, 32);
    const float inv = 1.0f / fmaxf(sqrtf(ssq), 1e-12f);
    if (fq == 0) RK[(size_t)tok * 8 + h] = rkp;
#pragma unroll
    for (int ct = 0; ct < 4; ++ct) { const int cl = 16 * ct + 4 * fq; float kap[4], bb[4];
#pragma unroll
        for (int r = 0; r < 4; ++r) { kap[r] = kkv[ct][r] * inv; bb[r] = kap[r] * av[ct][r]; }
        *(u32x2*)(ops + 0 * 64 + cl) = pack4(kap[0], kap[1], kap[2], kap[3]);
        *(u32x2*)(ops + 1 * 64 + cl) = pack4(bb[0], bb[1], bb[2], bb[3]); }
}
__device__ __forceinline__ void kbar_task(const bf16_t* QKV, float* KBAR, int task, int lane) {
    const int b = task / 48, j = (task / 6) % 8, h = task % 6;
    const bf16_t* p = QKV + ((size_t)b * SEQ + j * 256) * 1152 + 384 + h * 64 + lane; float acc = 0.f;
#pragma unroll 8
    for (int k = 0; k < 256; ++k) acc += bf2f(p[(size_t)k * 1152]);
    KBAR[((b * NH + h) * 8 + j) * 64 + lane] = acc * (1.0f / 256.0f);
}
__device__ __forceinline__ void gmlp_task(const Lay& L, const bf16_t* GM, bf16_t* MIXCAT, int task, LAS unsigned char* lds, int wave, int lane) {
    LAS bf16_t* vnT = (LAS bf16_t*)lds; constexpr int VP = 136;
    const int tok0 = task * 128;
    const f32x4 lg = *(const f32x4*)(L.gln_g + 4 * lane), lb = *(const f32x4*)(L.gln_b + 4 * lane);
    for (int i = 0; i < 16; ++i) { const int sl = wave * 16 + i; float v[4]; unpack4(*(const u32x2*)(GM + (size_t)(tok0 + sl) * 512 + 256 + 4 * lane), v);
#pragma unroll
        for (int r = 0; r < 4; ++r) v[r] = fgelu(v[r]);
        const float mean = wave_sum((v[0] + v[1]) + (v[2] + v[3])) * (1.0f / 256.0f);
        float q = 0.f;
#pragma unroll
        for (int r = 0; r < 4; ++r) { v[r] -= mean; q += v[r] * v[r]; }
        const float rstd = rsqrtf(wave_sum(q) * (1.0f / 256.0f) + 1e-6f);
        const unsigned p01 = cvt_pk_bf16(v[0] * rstd * lg.x + lb.x, v[1] * rstd * lg.y + lb.y), p23 = cvt_pk_bf16(v[2] * rstd * lg.z + lb.z, v[3] * rstd * lg.w + lb.w);
        vnT[(4 * lane + 0) * VP + sl] = (bf16_t)(p01 & 0xffff); vnT[(4 * lane + 1) * VP + sl] = (bf16_t)(p01 >> 16);
        vnT[(4 * lane + 2) * VP + sl] = (bf16_t)(p23 & 0xffff); vnT[(4 * lane + 3) * VP + sl] = (bf16_t)(p23 >> 16); }
    __syncthreads();
    const int fr = lane & 15, fq = lane >> 4, t = wave * 16 + fr, nkk = (wave * 16 + 15) / 32 + 1;
    for (int g = 0; g < 4; ++g) {
        bf16x8 Wf[4];
#pragma unroll
        for (int kk = 0; kk < 4; ++kk) { float w8[8];
            if (kk < nkk) { const float* wp = L.gw_s + ((size_t)g * 128 + t) * 128 + 32 * kk + 8 * fq; const f32x4 w0 = *(const f32x4*)wp, w1 = *(const f32x4*)(wp + 4);
                const float ww[8] = {w0.x, w0.y, w0.z, w0.w, w1.x, w1.y, w1.z, w1.w};
#pragma unroll
                for (int i = 0; i < 8; ++i) w8[i] = (32 * kk + 8 * fq + i <= t) ? ww[i] : 0.f;
            } else {
#pragma unroll
                for (int i = 0; i < 8; ++i) w8[i] = 0.f; }
            Wf[kk] = pack8(w8); }
        const float bs = L.gb_s[g * 128 + t];
#pragma unroll
        for (int ct = 0; ct < 4; ++ct) {
            f32x4 acc = {0.f, 0.f, 0.f, 0.f};
#pragma unroll
            for (int kk = 0; kk < 4; ++kk) if (kk < nkk)
                acc = __builtin_amdgcn_mfma_f32_16x16x32_bf16(*(const LAS bf16x8*)(vnT + (64 * g + 16 * ct + fr) * VP + 32 * kk + 8 * fq), Wf[kk], acc, 0, 0, 0);
            const int ch = 64 * g + 16 * ct + 4 * fq; float u[4]; unpack4(*(const u32x2*)(GM + (size_t)(tok0 + t) * 512 + ch), u);
            *(u32x2*)(MIXCAT + (size_t)(tok0 + t) * DM + 768 + ch) = pack4(fgelu(u[0]) * (acc[0] + bs), fgelu(u[1]) * (acc[1] + bs), fgelu(u[2]) * (acc[2] + bs), fgelu(u[3]) * (acc[3] + bs));
        }
    }
    __syncthreads();
}

__device__ __forceinline__ void scan_unit(const bf16_t* ops, float* Y, int b, int h, int row, int lane, LAS float* sl) {
    typedef float v2 __attribute__((ext_vector_type(2)));
    const int cg = lane & 15;
    v2 S01 = {0.f, 0.f}, S23 = {0.f, 0.f}; float ykeep = 0.f;
    const u32x4* gsrc = (const u32x4*)ops + (lane >> 3) * 48 + (lane & 7); u32x4 pf[4][6];
#pragma unroll
    for (int q = 0; q < 4; ++q)
#pragma unroll
        for (int k = 0; k < 6; ++k) pf[q][k] = gsrc[q * 384 + 8 * k];
    const LAS float* pl = sl + 4 * cg; const LAS float* pvv = sl + 320 + row;
    for (int tq = 0; tq < SEQ / 8; tq += 4) {
#pragma unroll
      for (int q = 0; q < 4; ++q) {
        const int t0 = (tq + q) * 8;
#pragma unroll
        for (int k = 0; k < 6; ++k) { float f[8]; unpack8(pf[q][k], f);
            if (k == 2) {
#pragma unroll
                for (int i = 0; i < 8; ++i) f[i] = 1.0f - f[i]; }
            LAS f32x4* d = (LAS f32x4*)(sl + (lane >> 3) * 384 + k * 64 + (lane & 7) * 8); d[0] = (f32x4){f[0], f[1], f[2], f[3]}; d[1] = (f32x4){f[4], f[5], f[6], f[7]}; }
        if (tq + q + 4 < SEQ / 8) {
#pragma unroll
            for (int k = 0; k < 6; ++k) pf[q][k] = gsrc[(size_t)(tq + q + 4) * 384 + 8 * k]; }
        LDS_WAIT();
        f32x4 kap = *(const LAS f32x4*)(pl), bb = *(const LAS f32x4*)(pl + 64), w4 = *(const LAS f32x4*)(pl + 128), k4 = *(const LAS f32x4*)(pl + 192), r4 = *(const LAS f32x4*)(pl + 256); float v = pvv[0];
#pragma unroll
        for (int tt = 0; tt < 8; ++tt) {
            f32x4 nkap, nbb, nw4, nk4, nr4; float nv;
            if (tt < 7) { const LAS float* qq = pl + (tt + 1) * 384; nkap = *(const LAS f32x4*)(qq); nbb = *(const LAS f32x4*)(qq + 64); nw4 = *(const LAS f32x4*)(qq + 128); nk4 = *(const LAS f32x4*)(qq + 192); nr4 = *(const LAS f32x4*)(qq + 256); nv = pvv[(tt + 1) * 384]; }
            v2 d = (v2){kap.x, kap.y} * S01; d = (v2){kap.z, kap.w} * S23 + d;
            const float sa = -ar16(d.x + d.y);
            const v2 sa2 = {sa, sa}, vv2 = {v, v};
            v2 t01 = sa2 * (v2){bb.x, bb.y}; t01 = vv2 * (v2){k4.x, k4.y} + t01; S01 = S01 * (v2){w4.x, w4.y} + t01;
            v2 t23 = sa2 * (v2){bb.z, bb.w}; t23 = vv2 * (v2){k4.z, k4.w} + t23; S23 = S23 * (v2){w4.z, w4.w} + t23;
            v2 e = (v2){r4.x, r4.y} * S01; e = (v2){r4.z, r4.w} * S23 + e;
            const float y = ar16(e.x + e.y);
            const int t = t0 + tt;
            if ((t & 15) == cg) ykeep = y;
            if ((t & 15) == 15) Y[((size_t)b * SEQ + (t - 15) + cg) * 384 + h * 64 + row] = ykeep;
            if (tt < 7) { kap = nkap; bb = nbb; w4 = nw4; k4 = nk4; r4 = nr4; v = nv; }
        }
        LDS_WAIT();
      }
    }
}
#define MOBA_LOAD(jj, ss) do { const int key0_ = (jj) * 256 + (ss) * 32; \
    _Pragma("unroll") for (int kt = 0; kt < 2; ++kt) { const bf16_t* krow = base + (size_t)(key0_ + 16 * kt + fr) * 1152 + 384 + h * 64; Kn[2 * kt] = *(const bf16x8*)(krow + 8 * fq); Kn[2 * kt + 1] = *(const bf16x8*)(krow + 32 + 8 * fq); } \
    _Pragma("unroll") for (int k = 0; k < 4; ++k) { const int u = lane + 64 * k; Vn[k] = *(const u32x4*)(base + (size_t)(key0_ + (u >> 3)) * 1152 + 768 + h * 64 + (u & 7) * 8); } } while (0)
__device__ __forceinline__ void moba_task(const bf16_t* QKV, const float* KBAR, bf16_t* MIXCAT, int task, int lane, LAS unsigned char* vl) {
    const int fr = lane & 15, fq = lane >> 4;
    const int qb = 7 - task / 768; int rem = task % 768; const int b = rem / 96; rem %= 96; const int h = rem / 16, qg = rem % 16;
    const int q0 = qb * 256 + qg * 16, qpos = q0 + fr;
    const bf16_t* base = QKV + (size_t)b * SEQ * 1152;
    const bf16_t* qrow = base + (size_t)qpos * 1152 + h * 64;
    bf16x8 Qf[2]; Qf[0] = *(const bf16x8*)(qrow + 8 * fq); Qf[1] = *(const bf16x8*)(qrow + 32 + 8 * fq);
    unsigned selmask = 0, pm = 1u << qb;
    { float qv[16]; unpack8(__builtin_bit_cast(u32x4, Qf[0]), qv); unpack8(__builtin_bit_cast(u32x4, Qf[1]), qv + 8);
      float sc[7];
#pragma unroll
      for (int j = 0; j < 7; ++j) { sc[j] = -INFINITY;
        if (j < qb) { const float* kb = KBAR + ((b * NH + h) * 8 + j) * 64; const f32x4 k0 = *(const f32x4*)(kb + 8 * fq), k1 = *(const f32x4*)(kb + 8 * fq + 4), k2 = *(const f32x4*)(kb + 32 + 8 * fq), k3 = *(const f32x4*)(kb + 36 + 8 * fq);
            float s = qv[0] * k0.x + qv[1] * k0.y + qv[2] * k0.z + qv[3] * k0.w + qv[4] * k1.x + qv[5] * k1.y + qv[6] * k1.z + qv[7] * k1.w
                    + qv[8] * k2.x + qv[9] * k2.y + qv[10] * k2.z + qv[11] * k2.w + qv[12] * k3.x + qv[13] * k3.y + qv[14] * k3.z + qv[15] * k3.w;
            s += __shfl_xor(s, 16); s += __shfl_xor(s, 32); sc[j] = s; } }
#pragma unroll
      for (int j = 0; j < 7; ++j) { int rank = 0;
#pragma unroll
        for (int i = 0; i < 7; ++i) if (i != j) rank += (i < qb) && (sc[i] > sc[j] || (sc[i] == sc[j] && i < j));
        const bool sel = (j < qb) && (rank < 3);
        if (sel) selmask |= 1u << j;
        if (__ballot(sel) != 0ull) pm |= 1u << j; } }
    pm = __builtin_amdgcn_readfirstlane(pm);
    const int n_own = (qg * 16 + 15) / 32 + 1;
    float m = -1e30f, l = 0.f; f32x4 O[4];
#pragma unroll
    for (int d = 0; d < 4; ++d) O[d] = (f32x4){0.f, 0.f, 0.f, 0.f};
    int j = __builtin_ctz(pm); pm &= pm - 1; int st = 0, ns = (j == qb) ? n_own : 8;
    bf16x8 Kn[4]; u32x4 Vn[4];
    MOBA_LOAD(j, st);
    for (;;) {
        bf16x8 Kc[4];
#pragma unroll
        for (int i = 0; i < 4; ++i) Kc[i] = Kn[i];
#pragma unroll
        for (int k = 0; k < 4; ++k) { const int u = lane + 64 * k; *(LAS u32x4*)(vl + (u >> 3) * 144 + (u & 7) * 16) = Vn[k]; }
        int j2 = j, st2 = st + 1; bool more = true;
        if (st2 == ns) { if (pm == 0u) more = false; else { j2 = __builtin_ctz(pm); pm &= pm - 1; st2 = 0; ns = (j2 == qb) ? n_own : 8; } }
        if (more) MOBA_LOAD(j2, st2);
        const bool own = (j == qb); const bool rowsel = own || ((selmask >> j) & 1u);
        const int key0 = j * 256 + st * 32;
        f32x4 sv[2];
#pragma unroll
        for (int kt = 0; kt < 2; ++kt) { f32x4 a = {0.f, 0.f, 0.f, 0.f};
            a = __builtin_amdgcn_mfma_f32_16x16x32_bf16(Kc[2 * kt], Qf[0], a, 0, 0, 0);
            a = __builtin_amdgcn_mfma_f32_16x16x32_bf16(Kc[2 * kt + 1], Qf[1], a, 0, 0, 0); sv[kt] = a; }
        float pv[8]; float mx = -INFINITY;
#pragma unroll
        for (int kt = 0; kt < 2; ++kt)
#pragma unroll
            for (int r = 0; r < 4; ++r) { const int kp = key0 + 16 * kt + 4 * fq + r; const bool ok = rowsel && (!own || kp <= qpos);
                const float x = ok ? sv[kt][r] * 0.125f : -INFINITY; pv[kt * 4 + r] = x; mx = fmaxf(mx, x); }
        mx = fmaxf(mx, __shfl_xor(mx, 16)); mx = fmaxf(mx, __shfl_xor(mx, 32));
        const float mnew = fmaxf(m, mx), alpha = __expf(m - mnew); m = mnew;
        float ps = 0.f;
#pragma unroll
        for (int i = 0; i < 8; ++i) { pv[i] = __expf(pv[i] - mnew); ps += pv[i]; }
        l = l * alpha + ps;
#pragma unroll
        for (int d = 0; d < 4; ++d) O[d] = O[d] * alpha;
        const bf16x8 Pf = pack8(pv);
#pragma unroll
        for (int d = 0; d < 4; ++d) { const LAS bf16_t* vp = (const LAS bf16_t*)(vl + (16 * d + fr) * 2); u32x4 w;
            w.x = (unsigned)vp[(4 * fq + 0) * 72] | ((unsigned)vp[(4 * fq + 1) * 72] << 16); w.y = (unsigned)vp[(4 * fq + 2) * 72] | ((unsigned)vp[(4 * fq + 3) * 72] << 16);
            w.z = (unsigned)vp[(16 + 4 * fq + 0) * 72] | ((unsigned)vp[(16 + 4 * fq + 1) * 72] << 16); w.w = (unsigned)vp[(16 + 4 * fq + 2) * 72] | ((unsigned)vp[(16 + 4 * fq + 3) * 72] << 16);
            O[d] = __builtin_amdgcn_mfma_f32_16x16x32_bf16(__builtin_bit_cast(bf16x8, w), Pf, O[d], 0, 0, 0); }
        if (!more) break;
        j = j2; st = st2;
    }
    l += __shfl_xor(l, 16); l += __shfl_xor(l, 32); const float inv = 1.0f / l;
    bf16_t* orow = MIXCAT + ((size_t)b * SEQ + qpos) * DM + 384 + h * 64 + 4 * fq;
#pragma unroll
    for (int d = 0; d < 4; ++d) *(u32x2*)(orow + 16 * d) = pack4(O[d][0] * inv, O[d][1] * inv, O[d][2] * inv, O[d][3] * inv);
}
__device__ __forceinline__ void rwkv_post(const Lay& L, const float* Y, const bf16_t* OPS, const float* RK, bf16_t* MIXCAT, int gw, int ngw, int lane) {
    const int cg = lane & 15, sub = lane >> 4;
    for (int it = gw; it < MTOK * NH / 4; it += ngw) {
        const int pr = it * 4 + sub, tok = pr / NH, h = pr % NH, c0 = 64 * h + 4 * cg;
        const f32x4 y = *(const f32x4*)(Y + (size_t)tok * 384 + c0);
        const float mean = ar16((y.x + y.y) + (y.z + y.w)) * (1.0f / 64.0f);
        const f32x4 d = y - mean; const float var = ar16((d.x * d.x + d.y * d.y) + (d.z * d.z + d.w * d.w)) * (1.0f / 64.0f);
        const float rstd = rsqrtf(var + 64e-5f), rk = RK[(size_t)tok * 8 + h];
        const int bh = (tok >> 11) * NH + h, s = tok & (SEQ - 1);
        float v[4], g[4]; unpack4(*(const u32x2*)(OPS + ((size_t)bh * SEQ + s) * 384 + 5 * 64 + 4 * cg), v);
        bf16_t* mp = MIXCAT + (size_t)tok * DM + c0; unpack4(*(const u32x2*)mp, g);
        const f32x4 lg = *(const f32x4*)(L.lnx_g + c0), lb = *(const f32x4*)(L.lnx_b + c0);
        *(u32x2*)mp = pack4((d.x * rstd * lg.x + lb.x + rk * v[0]) * g[0], (d.y * rstd * lg.y + lb.y + rk * v[1]) * g[1], (d.z * rstd * lg.z + lb.z + rk * v[2]) * g[2], (d.w * rstd * lg.w + lb.w + rk * v[3]) * g[3]);
    }
}
__device__ __forceinline__ int grab(unsigned* ctr) { int t = 0; if ((threadIdx.x & 63) == 0) t = (int)atomicAdd(ctr, 1u); return __builtin_amdgcn_readfirstlane(t); }


#define XB_TMO      128
#define XB_XCNT(j)  (256  + 64 * (j))
#define XB_XSUB(j)  (1280 + 64 * (j))
#define XB_XGEN(j)  (2304 + 64 * (j))
#define XB_TOP      3328
#define XB_TOPGEN   3392
#define XCD_BAR_WORDS 3456
#define XB_SPIN_CAP (1u << 18)
__device__ __forceinline__ unsigned xb_ld(unsigned* p)              { return __hip_atomic_load(p, __ATOMIC_RELAXED, __HIP_MEMORY_SCOPE_AGENT); }
__device__ __forceinline__ unsigned xb_add(unsigned* p, unsigned v) { return __hip_atomic_fetch_add(p, v, __ATOMIC_RELAXED, __HIP_MEMORY_SCOPE_AGENT); }
__device__ __forceinline__ unsigned xb_xcc_id() { return (unsigned)__builtin_amdgcn_s_getreg((3 << 11) | 20) & 0xFu; }
#define XB_SPIN(cond, bar) do { unsigned _sp = 0; while (cond) { __builtin_amdgcn_s_sleep(1); \
    if ((++_sp & 255u) == 0u) { if (xb_ld(&(bar)[XB_TMO])) break; if (_sp > XB_SPIN_CAP) { atomicAdd(&(bar)[XB_TMO], 1u); break; } } } } while (0)
struct XcdBarrier { unsigned* bar; unsigned x; volatile LAS unsigned* st; };
__device__ __forceinline__ void xcd_barrier_complete(unsigned* bar, unsigned x, unsigned& nloc, unsigned& nx) {
    const unsigned G = gridDim.x * gridDim.y * gridDim.z;
    unsigned sum, cnt, mine, sp = 0u;
    for (;;) {
        sum = 0u; cnt = 0u; mine = 0u;
#pragma unroll
        for (unsigned j = 0; j < 16; ++j) { const unsigned c = xb_ld(&bar[XB_XCNT(j)]); sum += c; cnt += (c > 0u) ? 1u : 0u; mine = (j == x) ? c : mine; }
        if (sum == G) break;
        __builtin_amdgcn_s_sleep(1);
        if ((++sp & 255u) == 0u) { if (xb_ld(&bar[XB_TMO])) break; if (sp > XB_SPIN_CAP) { atomicAdd(&bar[XB_TMO], 1u); break; } }
    }
    nloc = mine > 0u ? mine : 1u; nx = cnt > 0u ? cnt : 1u;
}
__device__ __forceinline__ void xcd_barrier(const XcdBarrier& b) {
    asm volatile("s_waitcnt vmcnt(0)" ::: "memory");
    __syncthreads();
    if (threadIdx.x == 0) {
        unsigned* bar = b.bar;
        __builtin_amdgcn_s_waitcnt(0);
        unsigned nloc = b.st[0], nx = b.st[1];
        if (nloc == 0u) { xcd_barrier_complete(bar, b.x, nloc, nx); b.st[0] = nloc; b.st[1] = nx; }
        const unsigned old = xb_add(&bar[XB_XSUB(b.x)], 1u);
        const unsigned gen = old / nloc;
        if (old + 1u == (gen + 1u) * nloc) {
            __builtin_amdgcn_fence(__ATOMIC_RELEASE, "agent");
            asm volatile("s_waitcnt vmcnt(0)" ::: "memory");
            const unsigned og = xb_add(&bar[XB_TOP], 1u);
            const unsigned tg = og / nx;
            if (og + 1u == (tg + 1u) * nx) xb_add(&bar[XB_TOPGEN], 1u);
            else XB_SPIN(xb_ld(&bar[XB_TOPGEN]) == tg, bar);
            __builtin_amdgcn_fence(__ATOMIC_ACQUIRE, "agent");
            xb_add(&bar[XB_XGEN(b.x)], 1u);
            asm volatile("s_waitcnt vmcnt(0)" ::: "memory");
        } else {
            XB_SPIN(xb_ld(&bar[XB_XGEN(b.x)]) == gen, bar);
            __builtin_amdgcn_fence(__ATOMIC_ACQUIRE, "agent");
            asm volatile("s_waitcnt vmcnt(0)" ::: "memory");
        }
    }
    __syncthreads();
}
typedef const __attribute__((address_space(4))) Params* KP;
__device__ __forceinline__ KP kargs() { KP p = (KP)__builtin_amdgcn_kernarg_segment_ptr(); asm volatile("" : "+s"(p)); return p; }
__device__ __forceinline__ int otid() { int t = threadIdx.x; asm volatile("" : "+v"(t)); return t; }
__device__ __forceinline__ Lay make_lay(KP kp, int l) {
    Lay L; unsigned char* ws = kp->ws; const unsigned char* wl = ws + WS_W + (size_t)l * WL_SIZE;
    L.mu = kp->in[3] + l * 1408; L.w0 = kp->in[4] + l * 384; L.a0 = kp->in[6] + l * 384; L.k_k = kp->in[9] + l * 384; L.k_a = kp->in[10] + l * 384; L.r_k = kp->in[11] + l * 384;
    L.lnx_g = kp->in[12] + l * 384; L.lnx_b = kp->in[13] + l * 384; L.gln_g = kp->in[14] + l * 256; L.gln_b = kp->in[15] + l * 256; L.gw_s = kp->in[16] + (size_t)l * 4 * 128 * 128; L.gb_s = kp->in[17] + l * 512;
    L.w2T = (const bf16_t*)(wl + WL_W2); L.a2T = (const bf16_t*)(wl + WL_A2); L.g2T = (const bf16_t*)(wl + WL_G2); return L;
}
#define PHASE_IDS() const int tid = otid(), lane = tid & 63, wave = __builtin_amdgcn_readfirstlane(tid >> 6), bid = blockIdx.x, G = gridDim.x, gw = bid * 8 + wave, ngw = G * 8; (void)lane; (void)wave; (void)gw; (void)ngw; (void)G
__global__ void __launch_bounds__(512, 2) fwd_megakernel(Params Pdummy) {
    extern __shared__ __attribute__((aligned(16))) unsigned char lds_raw[];
    cg::grid_group grid = cg::this_grid();
    LAS unsigned char* lds = (LAS unsigned char*)lds_raw;
    if (threadIdx.x < 2) ((volatile LAS unsigned*)(lds + 131072))[threadIdx.x] = 0u;
    __syncthreads();
    if (threadIdx.x == 0) { KP kp0 = kargs(); (void)xb_add(&((unsigned*)(kp0->ws + WS_BAR))[XB_XCNT(xb_xcc_id())], 1u); }
#define GRID_BAR() do { KP kpb_ = kargs(); XcdBarrier b_; b_.bar = (unsigned*)(kpb_->ws + WS_BAR); b_.x = xb_xcc_id(); b_.st = (volatile LAS unsigned*)(lds + 131072); xcd_barrier(b_); } while (0)

    { KP kp = kargs(); PHASE_IDS();
      p0_weights(kp->in[2], kp->in[18], kp->in[21], kp->in[22], kp->in[5], kp->in[7], kp->in[8], kp->ws, lds, gw, ngw, wave, lane);
      row_phase(kp->in[0], nullptr, nullptr, nullptr, kp->in[1], (bf16_t*)(kp->ws + WS_XB), gw, ngw, lane); }
    grid.sync();

#pragma unroll 1
    for (int l = 0; l < NLAYER; ++l) {
        { KP kp = kargs(); unsigned char* ws = kp->ws; const unsigned char* wl = ws + WS_W + (size_t)l * WL_SIZE;
          pg8::Gemm g{(const bf16_t*)(ws + WS_XB), (const bf16_t*)(wl + WL_IN), MTOK, 3072, 1024}; pg8::StaticOrder S; S.init(MTOK, 3072, gridDim.x, blockIdx.x);
          pg8::EpiProj E{(bf16_t*)(ws + WS_RW), (bf16_t*)(ws + WS_QKV), (bf16_t*)(ws + WS_GM)};
          pg8::gemm_phase<pg8::EpiProj, pg8::StaticOrder, false>(lds, g, S, E, nullptr); }
        GRID_BAR();
        for (int rep = 0; rep < REP_P2; ++rep) { if (rep) GRID_BAR();
        { KP kp = kargs(); PHASE_IDS(); unsigned char* ws = kp->ws; const Lay L = make_lay(kp, l);
          bf16_t* MIXCAT = (bf16_t*)(ws + WS_MIXCAT);
          if (bid < 128) gmlp_task(L, (const bf16_t*)(ws + WS_GM), MIXCAT, bid, lds, wave, lane);
          unsigned* ctr = (unsigned*)(ws + WS_CTL) + 64 * (2 * l + 4 * rep);
          for (;;) { const int t = grab(ctr); if (t >= 384 + 6144) break;
              if (t < 384) kbar_task((const bf16_t*)(ws + WS_QKV), (float*)(ws + WS_KBAR), t, lane);
              else rwkv_prep_task(L, (const bf16_t*)(ws + WS_RW), (bf16_t*)(ws + WS_OPS), MIXCAT, (float*)(ws + WS_RK), t - 384, lane); } } }
        GRID_BAR();
        for (int rep = 0; rep < REP_P3; ++rep) { if (rep) GRID_BAR();
        { KP kp = kargs(); PHASE_IDS(); unsigned char* ws = kp->ws;
          if (bid < 192 && wave < 4) { const int xcd = bid & 7, k = bid >> 3, bh = xcd * 6 + (k >> 2), rg = k & 3;
              __builtin_amdgcn_s_setprio(3);
              scan_unit((const bf16_t*)(ws + WS_OPS) + (size_t)bh * SEQ * 384, (float*)(ws + WS_Y), bh / NH, bh % NH, 16 * rg + 4 * wave + (lane >> 4), lane, (LAS float*)(lds + 36864 + wave * 12288));
              __builtin_amdgcn_s_setprio(0); }
          unsigned* ctr = (unsigned*)(ws + WS_CTL) + 64 * (2 * l + 1 + 4 * rep);
          for (;;) { const int t = grab(ctr); if (t >= 6144) break; moba_task((const bf16_t*)(ws + WS_QKV), (const float*)(ws + WS_KBAR), (bf16_t*)(ws + WS_MIXCAT), t, lane, lds + wave * 4608); } } }
        GRID_BAR();
        { KP kp = kargs(); PHASE_IDS(); unsigned char* ws = kp->ws; const Lay L = make_lay(kp, l);
          rwkv_post(L, (const float*)(ws + WS_Y), (const bf16_t*)(ws + WS_OPS), (const float*)(ws + WS_RK), (bf16_t*)(ws + WS_MIXCAT), gw, ngw, lane); }
        GRID_BAR();
        { KP kp = kargs(); unsigned char* ws = kp->ws; const unsigned char* wl = ws + WS_W + (size_t)l * WL_SIZE;
          pg8::Gemm g{(const bf16_t*)(ws + WS_MIXCAT), (const bf16_t*)(wl + WL_OUT), MTOK, 1024, 1024}; pg8::StaticOrder S; S.init(MTOK, 1024, gridDim.x, blockIdx.x); pg8::EpiF32 E{(float*)(ws + WS_MIXO), 1024};
          pg8::gemm_phase<pg8::EpiF32, pg8::StaticOrder, false>(lds, g, S, E, nullptr); }
        GRID_BAR();
        { KP kp = kargs(); PHASE_IDS(); unsigned char* ws = kp->ws;
          row_phase(l == 0 ? kp->in[0] : (const float*)kp->out, (const float*)(ws + WS_MIXO), kp->in[19] + l * DM, kp->out, kp->in[20] + l * DM, (bf16_t*)(ws + WS_XA), gw, ngw, lane); }
        GRID_BAR();
        { KP kp = kargs(); unsigned char* ws = kp->ws; const unsigned char* wl = ws + WS_W + (size_t)l * WL_SIZE;
          pg8::Gemm g{(const bf16_t*)(ws + WS_XA), (const bf16_t*)(wl + WL_FF), MTOK, 5632, 1024}; pg8::StaticOrder S; S.init(MTOK, 5632, gridDim.x, blockIdx.x); pg8::EpiSwiglu E{(bf16_t*)(ws + WS_FF)};
          pg8::gemm_phase<pg8::EpiSwiglu, pg8::StaticOrder, false>(lds, g, S, E, nullptr); }
        GRID_BAR();
        { KP kp = kargs(); unsigned char* ws = kp->ws; const unsigned char* wl = ws + WS_W + (size_t)l * WL_SIZE;
          pg8::Gemm g{(const bf16_t*)(ws + WS_FF), (const bf16_t*)(wl + WL_FF2), MTOK, 1024, DFF}; pg8::StaticOrder S; S.init(MTOK, 1024, gridDim.x, blockIdx.x); pg8::EpiF32 E{(float*)(ws + WS_MIXO2), 1024};
          pg8::gemm_phase<pg8::EpiF32, pg8::StaticOrder, false>(lds, g, S, E, nullptr); }
        GRID_BAR();
        { KP kp = kargs(); PHASE_IDS(); unsigned char* ws = kp->ws;
          row_phase((const float*)kp->out, (const float*)(ws + WS_MIXO2), kp->in[23] + l * DM, kp->out, l + 1 < NLAYER ? kp->in[1] + (l + 1) * DM : nullptr, l + 1 < NLAYER ? (bf16_t*)(ws + WS_XB) : nullptr, gw, ngw, lane); }
        if (l + 1 < NLAYER) GRID_BAR();
    }
}

extern "C" void kernel_launch(void* const* d_in, const int* in_sizes, int n_in, void* d_out, int out_size, void* d_ws, size_t ws_size, hipStream_t stream) {
    static int grid_blocks = 0;
    if (!grid_blocks) {
        int dev = 0, cus = 0, per_cu = 0;
        (void)hipGetDevice(&dev); (void)hipDeviceGetAttribute(&cus, hipDeviceAttributeMultiprocessorCount, dev);
        (void)hipFuncSetAttribute((const void*)fwd_megakernel, hipFuncAttributeMaxDynamicSharedMemorySize, LDS_BYTES);
        (void)hipOccupancyMaxActiveBlocksPerMultiprocessor(&per_cu, (const void*)fwd_megakernel, 512, LDS_BYTES);
        if (per_cu < 1) { fprintf(stderr, "kernel_launch: occupancy query says %d blocks per CU\n", per_cu); per_cu = 1; }
        grid_blocks = cus;
        if (ws_size < WS_END) fprintf(stderr, "kernel_launch: workspace too small: %zu < %zu\n", ws_size, (size_t)WS_END);
    }
    (void)hipMemsetAsync((unsigned char*)d_ws + WS_CTL, 0, CTL_ZERO_BYTES, stream);
    Params p{};
    for (int i = 0; i < 24; ++i) p.in[i] = (const float*)d_in[i];
    p.out = (float*)d_out; p.ws = (unsigned char*)d_ws;
    void* args[] = {&p};
    hipError_t e = hipLaunchCooperativeKernel((const void*)fwd_megakernel, dim3(grid_blocks), dim3(512), args, LDS_BYTES, stream);
    if (e != hipSuccess) fprintf(stderr, "cooperative launch failed: %s (grid %d)\n", hipGetErrorString(e), grid_blocks);
}
```

```cpp
#include <hip/hip_runtime.h>
#include <hip/hip_cooperative_groups.h>
#include <cstdio>
namespace cg = cooperative_groups;
#ifndef REP_P2
#define REP_P2 1
#endif
#ifndef REP_P3
#define REP_P3 1
#endif
namespace pg8 {
#define PG8_LAS __attribute__((address_space(3)))
typedef unsigned short bf16_t;
typedef short bf16x8 __attribute__((ext_vector_type(8)));
typedef float f32x4 __attribute__((ext_vector_type(4)));
typedef unsigned u32x4 __attribute__((ext_vector_type(4)));
constexpr int BM = 256, BK = 64, HALF = 128, HTB = HALF * BK * 2  , STAGE_BYTES = 8 * HTB, NXCD = 8, WGM = 8;

__host__ __device__ __forceinline__ int lds_byte(int r, int c) { const int st = (r >> 4) * 2 + (c >> 5), rr = r & 15, cc = c & 31, ob = rr * 64 + cc * 2; return st * 1024 + (ob ^ (((ob >> 9) & 1) << 5)); }
__host__ __device__ __forceinline__ void stage_rc(int b, int& R, int& C) { const int st = b / 1024, sb = b % 1024, swz = sb ^ (((sb >> 9) & 1) << 5); R = (st >> 1) * 16 + swz / 64; C = (st & 1) * 32 + (swz % 64) / 2; }
__host__ __device__ __forceinline__ int perm32(int rho) { const int n = rho >> 4, i = rho & 15; return 8 * (i >> 2) + 4 * n + (i & 3); }

struct Unit { int pm, pn; };
struct Gemm { const bf16_t* A; const bf16_t* Bt; int M, N, K; };

struct StaticOrder {
    int nM, nN, nwg, G, c;
    __host__ __device__ void init(int M, int N, int G_, int c_) { nM = M / BM; nN = N / BM; nwg = nM * nN; G = G_; c = c_; }
    __host__ __device__ bool next(int i, Unit& u) const {
        const long L = (long)i * G + c; if (L >= nwg) return false;
        int wgid = (int)L; { const int q = nwg / NXCD, r = nwg % NXCD, xcd = wgid % NXCD, off = wgid / NXCD; wgid = (xcd < r ? xcd * (q + 1) : r * (q + 1) + (xcd - r) * q) + off; }
        const int nig = WGM * nN, gid = wgid / nig, fm = gid * WGM, gsz = (nM - fm) < WGM ? (nM - fm) : WGM;
        u.pm = fm + ((wgid % nig) % gsz); u.pn = (wgid % nig) / gsz; return true;
    }
    __device__ __forceinline__ void a_ready(const Unit&) const {}
    __device__ __forceinline__ void done(const Unit&) const {}
};
__device__ __forceinline__ unsigned cvt_pk_bf16(float lo, float hi) { unsigned r; asm volatile("v_cvt_pk_bf16_f32 %0, %1, %2" : "=v"(r) : "v"(lo), "v"(hi)); return r; }
typedef float f32x2 __attribute__((ext_vector_type(2)));
struct EpiF32 {
    static constexpr bool PERM = false, AFTER_DRAIN = false;
    float* C; int ldc;
    __device__ __forceinline__ void operator()(const f32x4 (&acc)[2][2][4][2], const Unit& u, int wr, int wc, int fr, int fq) const {
        const int row0 = u.pm * BM + wr * 64 + fr, col0 = u.pn * BM + wc * 32 + 4 * fq;
#pragma unroll
        for (int ai = 0; ai < 2; ++ai)
#pragma unroll
            for (int m = 0; m < 4; ++m) { float* rowp = C + (size_t)(row0 + ai * HALF + m * 16) * ldc + col0;
#pragma unroll
                for (int bj = 0; bj < 2; ++bj)
#pragma unroll
                    for (int n = 0; n < 2; ++n) *(f32x4*)(rowp + bj * HALF + n * 16) = acc[ai][bj][m][n]; }
    }
};
struct EpiProj {
    static constexpr bool PERM = true, AFTER_DRAIN = false;
    bf16_t *RW, *QKV, *GM;
    __device__ __forceinline__ void operator()(const f32x4 (&acc)[2][2][4][2], const Unit& u, int wr, int wc, int fr, int fq) const {
        const int row0 = u.pm * BM + wr * 64 + fr;
#pragma unroll
        for (int bj = 0; bj < 2; ++bj) {
            const int hh = 2 * u.pn + bj; bf16_t* base; int ld, c0;
            if (hh < 11) { base = RW; ld = 1408; c0 = 128 * hh; } else if (hh < 20) { base = QKV; ld = 1152; c0 = 128 * (hh - 11); } else { base = GM; ld = 512; c0 = 128 * (hh - 20); }
            const int col = c0 + wc * 32 + 8 * fq;
#pragma unroll
            for (int ai = 0; ai < 2; ++ai)
#pragma unroll
                for (int m = 0; m < 4; ++m) { const f32x4 v0 = acc[ai][bj][m][0], v1 = acc[ai][bj][m][1];
                    u32x4 w; w.x = cvt_pk_bf16(v0[0], v0[1]); w.y = cvt_pk_bf16(v0[2], v0[3]); w.z = cvt_pk_bf16(v1[0], v1[1]); w.w = cvt_pk_bf16(v1[2], v1[3]);
                    *(u32x4*)(base + (size_t)(row0 + ai * HALF + m * 16) * ld + col) = w; }
        }
    }
};
__device__ __forceinline__ float silu_mul(float g, float u) { return g * __builtin_amdgcn_rcpf(1.0f + __expf(-g)) * u; }
struct EpiSwiglu {
    static constexpr bool PERM = true, AFTER_DRAIN = false;
    bf16_t* FF;
    __device__ __forceinline__ void operator()(const f32x4 (&acc)[2][2][4][2], const Unit& u, int wr, int wc, int fr, int fq) const {
        const int row0 = u.pm * BM + wr * 64 + fr, col = 128 * u.pn + wc * 32 + 8 * fq;
#pragma unroll
        for (int ai = 0; ai < 2; ++ai)
#pragma unroll
            for (int m = 0; m < 4; ++m) { const f32x4 g0 = acc[ai][0][m][0], g1 = acc[ai][0][m][1], u0 = acc[ai][1][m][0], u1 = acc[ai][1][m][1];
                u32x4 w; w.x = cvt_pk_bf16(silu_mul(g0[0], u0[0]), silu_mul(g0[1], u0[1])); w.y = cvt_pk_bf16(silu_mul(g0[2], u0[2]), silu_mul(g0[3], u0[3]));
                w.z = cvt_pk_bf16(silu_mul(g1[0], u1[0]), silu_mul(g1[1], u1[1])); w.w = cvt_pk_bf16(silu_mul(g1[2], u1[2]), silu_mul(g1[3], u1[3]));
                *(u32x4*)(FF + (size_t)(row0 + ai * HALF + m * 16) * 2816 + col) = w; }
    }
};
template <class Epi, class Sched, bool STAMP = false>
__device__ __forceinline__ void gemm_phase(PG8_LAS unsigned char* lds, const Gemm g, const Sched& S, const Epi& E, unsigned long long* stamps) {
    int tid_ = threadIdx.x; asm volatile("" : "+v"(tid_));
    const int tid = tid_, wid = __builtin_amdgcn_readfirstlane(tid >> 6), lane = tid & 63, wr = wid >> 2, wc = wid & 3, fr = lane & 15, fq = lane >> 4;
    const int K = g.K, nt = K / BK;
    int ts_lo = 0, ts_hi = 0, nts = 0; const unsigned long long rt_entry = STAMP ? (unsigned long long)wall_clock64() : 0ull;
#define PG8_STAMP() do { if (STAMP && wid == 0 && nts < 64) { const unsigned long long _c = (unsigned long long)clock64(); \
        ts_lo = (lane == nts) ? (int)(unsigned)_c : ts_lo; ts_hi = (lane == nts) ? (int)(unsigned)(_c >> 32) : ts_hi; ++nts; } } while (0)
    PG8_STAMP();
    unsigned voffA[2], voffB[2];
#pragma unroll
    for (int i = 0; i < 2; ++i) { int R, C; stage_rc(tid * 16 + i * 8192, R, C); const int Rb = Epi::PERM ? ((R & ~31) + perm32(R & 31)) : R;
        voffA[i] = (unsigned)(R * K + C) * 2u; voffB[i] = (unsigned)(Rb * K + C) * 2u; }
    const size_t kstep = (size_t)(BK * 2);
    const size_t hstep = (size_t)HALF * K * 2;
    const size_t tstep = 2 * hstep;
    const unsigned ldsw = (unsigned)wid * 1024u;
    const int aoff = lds_byte(wr * 64 + fr, fq * 8), boff = lds_byte(wc * 32 + fr, fq * 8);
#define PG8_SA(b, h) (((b) * 2 + (h)) * HTB)
#define PG8_SB(b, h) ((4 + (b) * 2 + (h)) * HTB)
#define PG8_STAGE(bufoff, gbase, voff) do { _Pragma("unroll") for (int _i = 0; _i < 2; ++_i) \
        __builtin_amdgcn_global_load_lds((const unsigned*)((const char*)(gbase) + (voff)[_i]), (PG8_LAS unsigned*)(lds + (bufoff) + ldsw + _i * 8192), 16, 0, 0); } while (0)
#define PG8_LDA(dst, b, h) do { _Pragma("unroll") for (int m = 0; m < 4; ++m) _Pragma("unroll") for (int k = 0; k < 2; ++k) dst[m][k] = *(const PG8_LAS bf16x8*)(lds + PG8_SA(b, h) + aoff + m * 2048 + k * 1024); } while (0)
#define PG8_LDB(dst, b, h) do { _Pragma("unroll") for (int n = 0; n < 2; ++n) _Pragma("unroll") for (int k = 0; k < 2; ++k) dst[n][k] = *(const PG8_LAS bf16x8*)(lds + PG8_SB(b, h) + boff + n * 2048 + k * 1024); } while (0)
#define PG8_MMA(ai, bj, At, Bt) do { __builtin_amdgcn_s_setprio(1); _Pragma("unroll") for (int m = 0; m < 4; ++m) _Pragma("unroll") for (int n = 0; n < 2; ++n) _Pragma("unroll") for (int k = 0; k < 2; ++k) \
        acc[ai][bj][m][n] = __builtin_amdgcn_mfma_f32_16x16x32_bf16(Bt[n][k], At[m][k], acc[ai][bj][m][n], 0, 0, 0); __builtin_amdgcn_s_setprio(0); } while (0)
#define PG8_WAIT_V(n) asm volatile("s_waitcnt vmcnt(" #n ")" ::: "memory")
#define PG8_WAIT_L(n) asm volatile("s_waitcnt lgkmcnt(" #n ")" ::: "memory")
#define PG8_BAR __builtin_amdgcn_s_barrier()
#define PG8_SCHED __builtin_amdgcn_sched_barrier(0)
    Unit cur, nxt; int ui = 0;
    if (!S.next(0, cur)) return;
    f32x4 acc[2][2][4][2];
#pragma unroll
    for (int a = 0; a < 2; ++a)
#pragma unroll
        for (int b = 0; b < 2; ++b)
#pragma unroll
            for (int m = 0; m < 4; ++m)
#pragma unroll
                for (int n = 0; n < 2; ++n) acc[a][b][m][n] = (f32x4){0.f, 0.f, 0.f, 0.f};
    bf16x8 At[4][2], B0[2][2], B1[2][2];
    const char* cA = (const char*)g.A + (size_t)cur.pm * tstep; const char* cB = (const char*)g.Bt + (size_t)cur.pn * tstep;
    S.a_ready(cur);
    PG8_STAGE(PG8_SB(0, 0), cB, voffB); PG8_STAGE(PG8_SA(0, 0), cA, voffA); PG8_STAGE(PG8_SB(0, 1), cB + hstep, voffB); PG8_STAGE(PG8_SA(0, 1), cA + hstep, voffA);
    if (wr == 1) PG8_BAR;
    PG8_WAIT_V(4); PG8_BAR;
    PG8_STAGE(PG8_SB(1, 0), cB + kstep, voffB); PG8_STAGE(PG8_SA(1, 0), cA + kstep, voffA); PG8_STAGE(PG8_SB(1, 1), cB + hstep + kstep, voffB);
    PG8_WAIT_V(6); PG8_BAR;
    PG8_STAMP();
    for (;;) {
        const bool has_next = S.next(ui + 1, nxt);
        const char* nA = has_next ? (const char*)g.A + (size_t)nxt.pm * tstep : cA; const char* nB = has_next ? (const char*)g.Bt + (size_t)nxt.pn * tstep : cB;
        for (int t = 0; t < nt; t += 2) {
            const bool last = (t == nt - 2);
            const char* a1 = cA + (size_t)(t + 1) * kstep;
            const char* a2 = last ? nA : cA + (size_t)(t + 2) * kstep; const char* b2 = last ? nB : cB + (size_t)(t + 2) * kstep;
            const char* a3 = a2 + kstep; const char* b3 = b2 + kstep;
            if (last && has_next) S.a_ready(nxt);
            PG8_LDB(B0, 0, 0); PG8_SCHED; PG8_LDA(At, 0, 0); PG8_STAGE(PG8_SA(1, 1), a1 + hstep, voffA);
            PG8_WAIT_L(8); PG8_BAR; PG8_WAIT_L(0); PG8_MMA(0, 0, At, B0); PG8_BAR; PG8_SCHED;
            PG8_LDB(B1, 0, 1); PG8_STAGE(PG8_SB(0, 0), b2, voffB);
            PG8_BAR; PG8_WAIT_L(0); PG8_MMA(0, 1, At, B1); PG8_BAR;
            PG8_LDA(At, 0, 1); PG8_STAGE(PG8_SA(0, 0), a2, voffA);
            PG8_BAR; PG8_WAIT_L(0); PG8_MMA(1, 0, At, B0); PG8_BAR; PG8_SCHED;
            PG8_STAGE(PG8_SB(0, 1), b2 + hstep, voffB);
            PG8_WAIT_V(6); PG8_BAR; PG8_MMA(1, 1, At, B1); PG8_BAR;
            PG8_LDB(B0, 1, 0); PG8_SCHED; PG8_LDA(At, 1, 0); PG8_STAGE(PG8_SA(0, 1), a2 + hstep, voffA);
            PG8_WAIT_L(8); PG8_BAR; PG8_WAIT_L(0); PG8_MMA(0, 0, At, B0); PG8_BAR; PG8_SCHED;
            PG8_LDB(B1, 1, 1); PG8_STAGE(PG8_SB(1, 0), b3, voffB);
            PG8_BAR; PG8_WAIT_L(0); PG8_MMA(0, 1, At, B1); PG8_BAR;
            PG8_LDA(At, 1, 1); PG8_STAGE(PG8_SA(1, 0), a3, voffA);
            PG8_BAR; PG8_WAIT_L(0); PG8_MMA(1, 0, At, B0); PG8_BAR; PG8_SCHED;
            PG8_STAGE(PG8_SB(1, 1), b3 + hstep, voffB);
            PG8_WAIT_V(6); PG8_BAR; PG8_MMA(1, 1, At, B1); PG8_BAR;
        }
        PG8_STAMP();
        if constexpr (!Epi::AFTER_DRAIN) { E(acc, cur, wr, wc, fr, fq); S.done(cur); }
        PG8_STAMP();
        if (!has_next) break;
#pragma unroll
        for (int a = 0; a < 2; ++a)
#pragma unroll
            for (int b = 0; b < 2; ++b)
#pragma unroll
                for (int m = 0; m < 4; ++m)
#pragma unroll
                    for (int n = 0; n < 2; ++n) acc[a][b][m][n] = (f32x4){0.f, 0.f, 0.f, 0.f};
        cur = nxt; cA = nA; cB = nB; ++ui;
    }
    PG8_WAIT_V(0);
    if (wr == 0) PG8_BAR;
    PG8_BAR;
    if constexpr (Epi::AFTER_DRAIN) { E.fused(acc, cur, wr, wc, fr, fq, lds, wid, lane); S.done(cur); }
    PG8_STAMP();
    if (STAMP && wid == 0) { stamps[lane] = lane < nts ? (((unsigned long long)(unsigned)ts_hi << 32) | (unsigned)ts_lo) : 0ull;
        if (lane == 62) stamps[62] = rt_entry; if (lane == 63) stamps[63] = (unsigned long long)wall_clock64(); }
#undef PG8_STAMP
#undef PG8_SA
#undef PG8_SB
#undef PG8_STAGE
#undef PG8_LDA
#undef PG8_LDB
#undef PG8_MMA
#undef PG8_WAIT_V
#undef PG8_WAIT_L
#undef PG8_BAR
#undef PG8_SCHED
}
}
#define LAS __attribute__((address_space(3)))
typedef unsigned short bf16_t;
typedef short bf16x8 __attribute__((ext_vector_type(8)));
typedef float f32x4 __attribute__((ext_vector_type(4)));
typedef unsigned u32x4 __attribute__((ext_vector_type(4)));
typedef unsigned u32x2 __attribute__((ext_vector_type(2)));
using pg8::cvt_pk_bf16;
constexpr int MTOK = 16384, DM = 1024, SEQ = 2048, NB = 8, NH = 6, DFF = 2816, NLAYER = 2;
constexpr size_t MiB = 1u << 20;
constexpr size_t WS_CTL = 0, WS_KBAR = 65536, WS_RK = 262144, WS_W = 1 * MiB;
constexpr size_t WL_IN = 0, WL_OUT = WL_IN + 3072ull * 1024 * 2, WL_FF = WL_OUT + 1024ull * 1024 * 2, WL_FF2 = WL_FF + 5632ull * 1024 * 2, WL_W2 = WL_FF2 + 1024ull * 2816 * 2,
                 WL_A2 = WL_W2 + 384 * 64 * 2, WL_G2 = WL_A2 + 384 * 64 * 2, WL_SIZE = WL_G2 + 384 * 128 * 2;
static_assert(WS_W + 2 * WL_SIZE <= 52 * MiB, "weights region");
constexpr size_t WS_RW = 52 * MiB, WS_QKV = 96 * MiB, WS_GM = 132 * MiB, WS_U = 148 * MiB, WS_XB = 220 * MiB, WS_END = 252 * MiB;
constexpr size_t WS_Y = WS_RW, WS_MIXO = WS_RW, WS_FF = WS_RW, WS_XA = WS_U, WS_MIXO2 = WS_U + 8 * MiB, WS_OPS = WS_U, WS_MIXCAT = WS_XB;
constexpr int LDS_BYTES = 131072 + 64;
constexpr size_t WS_BAR = 4096;
constexpr int CTL_ZERO_BYTES = 4096 + 3456 * 4;

__device__ __forceinline__ float bf2f(bf16_t b) { return __uint_as_float(((unsigned)b) << 16); }
__device__ __forceinline__ float bflo(unsigned u) { return __uint_as_float(u << 16); }
__device__ __forceinline__ float bfhi(unsigned u) { return __uint_as_float(u & 0xffff0000u); }
__device__ __forceinline__ float wave_sum(float v) {
#pragma unroll
    for (int o = 1; o < 64; o <<= 1) v += __shfl_xor(v, o);
    return v;
}
template <int CTRL> __device__ __forceinline__ float dppf(float x) { return __int_as_float(__builtin_amdgcn_update_dpp(0, __float_as_int(x), CTRL, 0xF, 0xF, true)); }
__device__ __forceinline__ float ar16(float x) {
    x += dppf<0xB1>(x); x += dppf<0x4E>(x); x += dppf<0x141>(x); x += dppf<0x140>(x); return x;
}
__device__ __forceinline__ float fsigmoid(float x) { return 1.0f / (1.0f + __expf(-x)); }
__device__ __forceinline__ float ftanh(float x) { const float e = __expf(-2.0f * fabsf(x)); const float t = (1.0f - e) / (1.0f + e); return x < 0.f ? -t : t; }
__device__ __forceinline__ float fgelu(float x) { return 0.5f * x * (1.0f + ftanh(0.7978845608028654f * (x + 0.044715f * x * x * x))); }
__device__ __forceinline__ bf16x8 pack8(const float* f) { u32x4 w; w.x = cvt_pk_bf16(f[0], f[1]); w.y = cvt_pk_bf16(f[2], f[3]); w.z = cvt_pk_bf16(f[4], f[5]); w.w = cvt_pk_bf16(f[6], f[7]); return __builtin_bit_cast(bf16x8, w); }
__device__ __forceinline__ void unpack8(u32x4 w, float* f) { f[0] = bflo(w.x); f[1] = bfhi(w.x); f[2] = bflo(w.y); f[3] = bfhi(w.y); f[4] = bflo(w.z); f[5] = bfhi(w.z); f[6] = bflo(w.w); f[7] = bfhi(w.w); }
__device__ __forceinline__ void unpack4(u32x2 w, float* f) { f[0] = bflo(w.x); f[1] = bfhi(w.x); f[2] = bflo(w.y); f[3] = bfhi(w.y); }
__device__ __forceinline__ u32x2 pack4(float a, float b, float c, float d) { u32x2 w; w.x = cvt_pk_bf16(a, b); w.y = cvt_pk_bf16(c, d); return w; }
#define LDS_WAIT() asm volatile("s_waitcnt lgkmcnt(0)" ::: "memory")

struct Params { const float* in[24]; float* out; unsigned char* ws; };

__device__ __forceinline__ void transpose_item(const float* W, int K, int N, bf16_t* WT, int k0, int n0, int drow, LAS float* scr, int lane) {
    float tv[32];
#pragma unroll
    for (int i = 0; i < 32; ++i) tv[i] = W[(size_t)(k0 + 2 * i + (lane >> 5)) * N + n0 + (lane & 31)];
#pragma unroll
    for (int i = 0; i < 32; ++i) scr[(2 * i + (lane >> 5)) * 33 + (lane & 31)] = tv[i];
    LDS_WAIT();
    const int c = lane & 7;
#pragma unroll
    for (int j = 0; j < 4; ++j) { const int n = (lane >> 3) + 8 * j; const LAS float* s = scr + (8 * c) * 33 + n;
        u32x4 o; o.x = cvt_pk_bf16(s[0 * 33], s[1 * 33]); o.y = cvt_pk_bf16(s[2 * 33], s[3 * 33]); o.z = cvt_pk_bf16(s[4 * 33], s[5 * 33]); o.w = cvt_pk_bf16(s[6 * 33], s[7 * 33]);
        *(u32x4*)(WT + (size_t)(drow + n) * K + k0 + 8 * c) = o; }
    LDS_WAIT();
}
__device__ __forceinline__ void transpose_mat(const float* W, int K, int N, bf16_t* WT, int item, bool swiglu, LAS float* scr, int lane) {
    const int nblk = N / 32, kb = item / nblk, nb = item % nblk, n0 = 32 * nb;
    int drow = n0;
    if (swiglu) { if (n0 < DFF) drow = 256 * (n0 / 128) + (n0 % 128); else { const int q = n0 - DFF; drow = 256 * (q / 128) + 128 + (q % 128); } }
    transpose_item(W, K, N, WT, 64 * kb, n0, drow, scr, lane);
}
__device__ __forceinline__ void p0_weights(const float* w_in, const float* w_out, const float* w_ffi, const float* w_ffo, const float* w2, const float* a2, const float* g2, unsigned char* ws, LAS unsigned char* lds, int gw, int ngw, int wave, int lane) {
    LAS float* scr = (LAS float*)(lds + wave * 8448);
    constexpr int I_IN = 16 * 96, I_OUT = 16 * 32, I_FF = 16 * 176, I_FF2 = 44 * 32, I_W2 = 12, I_A2 = 12, I_G2 = 24, I_L = I_IN + I_OUT + I_FF + I_FF2 + I_W2 + I_A2 + I_G2;
    for (int it = gw; it < NLAYER * I_L; it += ngw) {
        const int l = it / I_L; int r = it % I_L; unsigned char* wl = ws + WS_W + (size_t)l * WL_SIZE;
        if (r < I_IN) { transpose_mat(w_in + (size_t)l * 1024 * 3072, 1024, 3072, (bf16_t*)(wl + WL_IN), r, false, scr, lane); continue; } r -= I_IN;
        if (r < I_OUT) { transpose_mat(w_out + (size_t)l * 1024 * 1024, 1024, 1024, (bf16_t*)(wl + WL_OUT), r, false, scr, lane); continue; } r -= I_OUT;
        if (r < I_FF) { transpose_mat(w_ffi + (size_t)l * 1024 * 5632, 1024, 5632, (bf16_t*)(wl + WL_FF), r, true, scr, lane); continue; } r -= I_FF;
        if (r < I_FF2) { transpose_mat(w_ffo + (size_t)l * 2816 * 1024, 2816, 1024, (bf16_t*)(wl + WL_FF2), r, false, scr, lane); continue; } r -= I_FF2;
        if (r < I_W2) { transpose_mat(w2 + (size_t)l * 64 * 384, 64, 384, (bf16_t*)(wl + WL_W2), r, false, scr, lane); continue; } r -= I_W2;
        if (r < I_A2) { transpose_mat(a2 + (size_t)l * 64 * 384, 64, 384, (bf16_t*)(wl + WL_A2), r, false, scr, lane); continue; } r -= I_A2;
        transpose_mat(g2 + (size_t)l * 128 * 384, 128, 384, (bf16_t*)(wl + WL_G2), r, false, scr, lane);
    }
}
__device__ __forceinline__ void row_phase(const float* res, const float* add, const float* g_add, float* res_out, const float* g_xn, bf16_t* xn, int gw, int ngw, int lane) {
    f32x4 x[4], a[4], nx[4], na[4];
    if (gw < MTOK) {
#pragma unroll
        for (int j = 0; j < 4; ++j) { nx[j] = ((const f32x4*)(res + (size_t)gw * DM))[lane + 64 * j]; if (add) na[j] = ((const f32x4*)(add + (size_t)gw * DM))[lane + 64 * j]; } }
    for (int m = gw; m < MTOK; m += ngw) {
#pragma unroll
        for (int j = 0; j < 4; ++j) { x[j] = nx[j]; if (add) a[j] = na[j]; }
        const int mn = m + ngw;
        if (mn < MTOK) {
#pragma unroll
            for (int j = 0; j < 4; ++j) { nx[j] = ((const f32x4*)(res + (size_t)mn * DM))[lane + 64 * j]; if (add) na[j] = ((const f32x4*)(add + (size_t)mn * DM))[lane + 64 * j]; } }
        if (add) {
            float ss = 0.f;
#pragma unroll
            for (int j = 0; j < 4; ++j) ss += (a[j].x * a[j].x + a[j].y * a[j].y) + (a[j].z * a[j].z + a[j].w * a[j].w);
            const float rs = rsqrtf(wave_sum(ss) * (1.0f / DM) + 1e-6f);
            f32x4* orow = (f32x4*)(res_out + (size_t)m * DM) + lane;
#pragma unroll
            for (int j = 0; j < 4; ++j) { const f32x4 g = ((const f32x4*)g_add)[lane + 64 * j]; x[j] = x[j] + a[j] * rs * g; orow[64 * j] = x[j]; }
        }
        if (xn) {
            float ss = 0.f;
#pragma unroll
            for (int j = 0; j < 4; ++j) ss += (x[j].x * x[j].x + x[j].y * x[j].y) + (x[j].z * x[j].z + x[j].w * x[j].w);
            const float rs = rsqrtf(wave_sum(ss) * (1.0f / DM) + 1e-6f);
            u32x2* o8 = (u32x2*)(xn + (size_t)m * DM) + lane;
#pragma unroll
            for (int j = 0; j < 4; ++j) { const f32x4 g = ((const f32x4*)g_xn)[lane + 64 * j]; o8[64 * j] = pack4(x[j].x * rs * g.x, x[j].y * rs * g.y, x[j].z * rs * g.z, x[j].w * rs * g.w); }
        }
    }
}

struct Lay { const float *mu, *w0, *a0, *k_k, *k_a, *r_k, *lnx_g, *lnx_b, *gln_g, *gln_b, *gw_s, *gb_s; const bf16_t *w2T, *a2T, *g2T; };
__device__ __forceinline__ void shifted8(const bf16_t* row, bool hp, const float* mu, int col, float* o) {
    float c[8], p[8]; unpack8(*(const u32x4*)(row + col), c);
    if (hp) unpack8(*(const u32x4*)(row - 1408 + col), p); else {
#pragma unroll
        for (int i = 0; i < 8; ++i) p[i] = 0.f; }
    const f32x4 m0 = *(const f32x4*)(mu + col), m1 = *(const f32x4*)(mu + col + 4); const float mm[8] = {m0.x, m0.y, m0.z, m0.w, m1.x, m1.y, m1.z, m1.w};
#pragma unroll
    for (int i = 0; i < 8; ++i) o[i] = c[i] + mm[i] * (p[i] - c[i]);
}
__device__ __forceinline__ void shifted4(const bf16_t* row, bool hp, const float* mu, int col, float* o) {
    float c[4], p[4]; unpack4(*(const u32x2*)(row + col), c);
    if (hp) unpack4(*(const u32x2*)(row - 1408 + col), p); else { p[0] = p[1] = p[2] = p[3] = 0.f; }
    const f32x4 m0 = *(const f32x4*)(mu + col); const float mm[4] = {m0.x, m0.y, m0.z, m0.w};
#pragma unroll
    for (int i = 0; i < 4; ++i) o[i] = c[i] + mm[i] * (p[i] - c[i]);
}
constexpr int PA_PITCH = 264, PW_OFF = 33792, PW_HEAD = 64 * 72 * 2 * 2 + 64 * 136 * 2;
__device__ __forceinline__ void rwkv_prep_block(const Lay& L, const bf16_t* RW, bf16_t* OPS, bf16_t* MIXCAT, float* RK, int bt, LAS unsigned char* lds, int tid, int wave, int lane) {
    LAS bf16_t* Ap = (LAS bf16_t*)lds;
    { const int tl = tid >> 3, ch = tid & 7, tok = bt * 64 + tl; const bool hp = (tok & (SEQ - 1)) > 0; const bf16_t* row = RW + (size_t)tok * 1408;
#pragma unroll
      for (int i = 0; i < 4; ++i) { const int c = ch * 32 + i * 8; float t8[8]; shifted8(row, hp, L.mu, 1152 + c, t8);
          if (ch < 2) {
#pragma unroll
              for (int e = 0; e < 8; ++e) t8[e] = ftanh(t8[e]); }
          else if (ch >= 4) {
#pragma unroll
              for (int e = 0; e < 8; ++e) t8[e] = fsigmoid(t8[e]); }
          *(LAS bf16x8*)(Ap + tl * PA_PITCH + c) = pack8(t8); } }
    const int fr = lane & 15, fq = lane >> 4, tg = wave & 3, hh = wave >> 2;
    const int tok = bt * 64 + tg * 16 + fr, s = tok & (SEQ - 1); const bool hp = s > 0;
    const bf16_t* row = RW + (size_t)tok * 1408;
#pragma unroll 1
    for (int rd = 0; rd < 3; ++rd) {
        __syncthreads();
#pragma unroll
        for (int q = 0; q < 2; ++q) { const int hq = 2 * rd + q; LAS unsigned char* wb = lds + PW_OFF + q * PW_HEAD;
            { const int r = tid >> 3, c8 = (tid & 7) * 8;
              *(LAS u32x4*)(wb + (r * 72 + c8) * 2) = *(const u32x4*)(L.w2T + (size_t)(64 * hq + r) * 64 + c8);
              *(LAS u32x4*)(wb + 9216 + (r * 72 + c8) * 2) = *(const u32x4*)(L.a2T + (size_t)(64 * hq + r) * 64 + c8); }
#pragma unroll
            for (int i = 0; i < 2; ++i) { const int u = tid + 512 * i, r = u >> 4, c8 = (u & 15) * 8;
              *(LAS u32x4*)(wb + 18432 + (r * 136 + c8) * 2) = *(const u32x4*)(L.g2T + (size_t)(64 * hq + r) * 128 + c8); } }
        __syncthreads();
        const int h = 2 * rd + hh;
        const LAS bf16_t* Wl = (const LAS bf16_t*)(lds + PW_OFF + hh * PW_HEAD); const LAS bf16_t* Al = Wl + 64 * 72; const LAS bf16_t* Gl = Wl + 2 * 64 * 72;
        const LAS bf16_t* Arow = Ap + (tg * 16 + fr) * PA_PITCH + 8 * fq;
        const int bh = (tok >> 11) * NH + h;
        bf16_t* ops = OPS + ((size_t)bh * SEQ + s) * 384;
        float kkv[4][4], av[4][4]; float ssq = 0.f, rkp = 0.f;
#pragma unroll
        for (int ct = 0; ct < 4; ++ct) {
            const int wr_ = 16 * ct + fr;
            f32x4 accw = {0.f, 0.f, 0.f, 0.f}, acca = {0.f, 0.f, 0.f, 0.f}, accg = {0.f, 0.f, 0.f, 0.f};
#pragma unroll
            for (int kk = 0; kk < 2; ++kk) {
                accw = __builtin_amdgcn_mfma_f32_16x16x32_bf16(*(const LAS bf16x8*)(Wl + wr_ * 72 + 32 * kk + 8 * fq), *(const LAS bf16x8*)(Arow + 32 * kk), accw, 0, 0, 0);
                acca = __builtin_amdgcn_mfma_f32_16x16x32_bf16(*(const LAS bf16x8*)(Al + wr_ * 72 + 32 * kk + 8 * fq), *(const LAS bf16x8*)(Arow + 64 + 32 * kk), acca, 0, 0, 0); }
#pragma unroll
            for (int kk = 0; kk < 4; ++kk)
                accg = __builtin_amdgcn_mfma_f32_16x16x32_bf16(*(const LAS bf16x8*)(Gl + wr_ * 136 + 32 * kk + 8 * fq), *(const LAS bf16x8*)(Arow + 128 + 32 * kk), accg, 0, 0, 0);
            const int cl = 16 * ct + 4 * fq, c0 = 64 * h + cl;
            float rs[4], ks[4], vs[4]; shifted4(row, hp, L.mu, c0, rs); shifted4(row, hp, L.mu, 384 + c0, ks); shifted4(row, hp, L.mu, 768 + c0, vs);
            const f32x4 w0 = *(const f32x4*)(L.w0 + c0), a0 = *(const f32x4*)(L.a0 + c0), k_k = *(const f32x4*)(L.k_k + c0), k_a = *(const f32x4*)(L.k_a + c0), r_k = *(const f32x4*)(L.r_k + c0);
            float ev[4], kp[4];
#pragma unroll
            for (int r = 0; r < 4; ++r) {
                const float wv = -(w0[r] + accw[r]);
                const float sp = fmaxf(wv, 0.f) + __logf(1.0f + __expf(-fabsf(wv)));
                ev[r] = 1.0f - __expf(-__expf(-sp - 0.5f));
                const float a = fsigmoid(a0[r] + acca[r]); av[ct][r] = a;
                const float kk_ = ks[r] * k_k[r]; kkv[ct][r] = kk_; ssq += kk_ * kk_;
                kp[r] = ks[r] * (1.0f + (a - 1.0f) * k_a[r]); rkp += rs[r] * kp[r] * r_k[r];
            }
            *(u32x2*)(ops + 2 * 64 + cl) = pack4(ev[0], ev[1], ev[2], ev[3]);
            *(u32x2*)(ops + 3 * 64 + cl) = pack4(kp[0], kp[1], kp[2], kp[3]);
            *(u32x2*)(ops + 4 * 64 + cl) = pack4(rs[0], rs[1], rs[2], rs[3]);
            *(u32x2*)(ops + 5 * 64 + cl) = pack4(vs[0], vs[1], vs[2], vs[3]);
            *(u32x2*)(MIXCAT + (size_t)tok * DM + c0) = pack4(accg[0], accg[1], accg[2], accg[3]);
        }
        ssq += __shfl_xor(ssq, 16); ssq += __shfl_xor(ssq, 32); rkp += __shfl_xor(rkp, 16); rkp += __shfl_xor(rkp, 32);
        const float inv = 1.0f / fmaxf(sqrtf(ssq), 1e-12f);
        if (fq == 0) RK[(size_t)tok * 8 + h] = rkp;
#pragma unroll
        for (int ct = 0; ct < 4; ++ct) { const int cl = 16 * ct + 4 * fq; float kap[4], bb[4];
#pragma unroll
            for (int r = 0; r < 4; ++r) { kap[r] = kkv[ct][r] * inv; bb[r] = kap[r] * av[ct][r]; }
            *(u32x2*)(ops + 0 * 64 + cl) = pack4(kap[0], kap[1], kap[2], kap[3]);
            *(u32x2*)(ops + 1 * 64 + cl) = pack4(bb[0], bb[1], bb[2], bb[3]); }
    }
    __syncthreads();
}
__device__ __forceinline__ void kbar_task(const bf16_t* QKV, float* KBAR, int task, int lane) {
    const int b = task / 48, j = (task / 6) % 8, h = task % 6;
    const bf16_t* p = QKV + ((size_t)b * SEQ + j * 256 + (lane >> 3)) * 1152 + 384 + h * 64 + (lane & 7) * 8; float acc[8];
#pragma unroll
    for (int i = 0; i < 8; ++i) acc[i] = 0.f;
#pragma unroll 8
    for (int k = 0; k < 32; ++k) { float f[8]; unpack8(*(const u32x4*)(p + (size_t)k * 8 * 1152), f);
#pragma unroll
        for (int i = 0; i < 8; ++i) acc[i] += f[i]; }
#pragma unroll
    for (int i = 0; i < 8; ++i) { acc[i] += __shfl_xor(acc[i], 8); acc[i] += __shfl_xor(acc[i], 16); acc[i] += __shfl_xor(acc[i], 32); }
    if (lane < 8) { float* o = KBAR + ((b * NH + h) * 8 + j) * 64 + lane * 8;
        *(f32x4*)o = (f32x4){acc[0], acc[1], acc[2], acc[3]} * (1.0f / 256.0f); *(f32x4*)(o + 4) = (f32x4){acc[4], acc[5], acc[6], acc[7]} * (1.0f / 256.0f); }
}
__device__ __forceinline__ void gmlp_task(const Lay& L, const bf16_t* GM, bf16_t* MIXCAT, int task, LAS unsigned char* lds, int wave, int lane) {
    LAS bf16_t* vnT = (LAS bf16_t*)lds; constexpr int VP = 136;
    const int tok0 = task * 128;
    const f32x4 lg = *(const f32x4*)(L.gln_g + 4 * lane), lb = *(const f32x4*)(L.gln_b + 4 * lane);
    for (int i = 0; i < 16; ++i) { const int sl = wave * 16 + i; float v[4]; unpack4(*(const u32x2*)(GM + (size_t)(tok0 + sl) * 512 + 256 + 4 * lane), v);
#pragma unroll
        for (int r = 0; r < 4; ++r) v[r] = fgelu(v[r]);
        const float mean = wave_sum((v[0] + v[1]) + (v[2] + v[3])) * (1.0f / 256.0f);
        float q = 0.f;
#pragma unroll
        for (int r = 0; r < 4; ++r) { v[r] -= mean; q += v[r] * v[r]; }
        const float rstd = rsqrtf(wave_sum(q) * (1.0f / 256.0f) + 1e-6f);
        const unsigned p01 = cvt_pk_bf16(v[0] * rstd * lg.x + lb.x, v[1] * rstd * lg.y + lb.y), p23 = cvt_pk_bf16(v[2] * rstd * lg.z + lb.z, v[3] * rstd * lg.w + lb.w);
        vnT[(4 * lane + 0) * VP + sl] = (bf16_t)(p01 & 0xffff); vnT[(4 * lane + 1) * VP + sl] = (bf16_t)(p01 >> 16);
        vnT[(4 * lane + 2) * VP + sl] = (bf16_t)(p23 & 0xffff); vnT[(4 * lane + 3) * VP + sl] = (bf16_t)(p23 >> 16); }
    __syncthreads();
    const int fr = lane & 15, fq = lane >> 4, t = wave * 16 + fr, nkk = (wave * 16 + 15) / 32 + 1;
    for (int g = 0; g < 4; ++g) {
        bf16x8 Wf[4];
#pragma unroll
        for (int kk = 0; kk < 4; ++kk) { float w8[8];
            if (kk < nkk) { const float* wp = L.gw_s + ((size_t)g * 128 + t) * 128 + 32 * kk + 8 * fq; const f32x4 w0 = *(const f32x4*)wp, w1 = *(const f32x4*)(wp + 4);
                const float ww[8] = {w0.x, w0.y, w0.z, w0.w, w1.x, w1.y, w1.z, w1.w};
#pragma unroll
                for (int i = 0; i < 8; ++i) w8[i] = (32 * kk + 8 * fq + i <= t) ? ww[i] : 0.f;
            } else {
#pragma unroll
                for (int i = 0; i < 8; ++i) w8[i] = 0.f; }
            Wf[kk] = pack8(w8); }
        const float bs = L.gb_s[g * 128 + t];
#pragma unroll
        for (int ct = 0; ct < 4; ++ct) {
            f32x4 acc = {0.f, 0.f, 0.f, 0.f};
#pragma unroll
            for (int kk = 0; kk < 4; ++kk) if (kk < nkk)
                acc = __builtin_amdgcn_mfma_f32_16x16x32_bf16(*(const LAS bf16x8*)(vnT + (64 * g + 16 * ct + fr) * VP + 32 * kk + 8 * fq), Wf[kk], acc, 0, 0, 0);
            const int ch = 64 * g + 16 * ct + 4 * fq; float u[4]; unpack4(*(const u32x2*)(GM + (size_t)(tok0 + t) * 512 + ch), u);
            *(u32x2*)(MIXCAT + (size_t)(tok0 + t) * DM + 768 + ch) = pack4(fgelu(u[0]) * (acc[0] + bs), fgelu(u[1]) * (acc[1] + bs), fgelu(u[2]) * (acc[2] + bs), fgelu(u[3]) * (acc[3] + bs));
        }
    }
    __syncthreads();
}

__device__ __forceinline__ void scan_unit(const bf16_t* ops, float* Y, int b, int h, int row, int lane, LAS float* sl) {
    typedef float v2 __attribute__((ext_vector_type(2)));
    const int cg = lane & 15;
    v2 S01 = {0.f, 0.f}, S23 = {0.f, 0.f}; float ykeep = 0.f;
    const u32x4* gsrc = (const u32x4*)ops + (lane >> 3) * 48 + (lane & 7); u32x4 pf[4][6];
#pragma unroll
    for (int q = 0; q < 4; ++q)
#pragma unroll
        for (int k = 0; k < 6; ++k) pf[q][k] = gsrc[q * 384 + 8 * k];
    const LAS float* pl = sl + 4 * cg; const LAS float* pvv = sl + 320 + row;
    for (int tq = 0; tq < SEQ / 8; tq += 4) {
#pragma unroll
      for (int q = 0; q < 4; ++q) {
        const int t0 = (tq + q) * 8;
#pragma unroll
        for (int k = 0; k < 6; ++k) { float f[8]; unpack8(pf[q][k], f);
            if (k == 2) {
#pragma unroll
                for (int i = 0; i < 8; ++i) f[i] = 1.0f - f[i]; }
            LAS f32x4* d = (LAS f32x4*)(sl + (lane >> 3) * 384 + k * 64 + (lane & 7) * 8); d[0] = (f32x4){f[0], f[1], f[2], f[3]}; d[1] = (f32x4){f[4], f[5], f[6], f[7]}; }
        if (tq + q + 4 < SEQ / 8) {
#pragma unroll
            for (int k = 0; k < 6; ++k) pf[q][k] = gsrc[(size_t)(tq + q + 4) * 384 + 8 * k]; }
        LDS_WAIT();
        f32x4 kap = *(const LAS f32x4*)(pl), bb = *(const LAS f32x4*)(pl + 64), w4 = *(const LAS f32x4*)(pl + 128), k4 = *(const LAS f32x4*)(pl + 192), r4 = *(const LAS f32x4*)(pl + 256); float v = pvv[0];
#pragma unroll
        for (int tt = 0; tt < 8; ++tt) {
            f32x4 nkap, nbb, nw4, nk4, nr4; float nv;
            if (tt < 7) { const LAS float* qq = pl + (tt + 1) * 384; nkap = *(const LAS f32x4*)(qq); nbb = *(const LAS f32x4*)(qq + 64); nw4 = *(const LAS f32x4*)(qq + 128); nk4 = *(const LAS f32x4*)(qq + 192); nr4 = *(const LAS f32x4*)(qq + 256); nv = pvv[(tt + 1) * 384]; }
            v2 d = (v2){kap.x, kap.y} * S01; d = (v2){kap.z, kap.w} * S23 + d;
            const float sa = -ar16(d.x + d.y);
            const v2 sa2 = {sa, sa}, vv2 = {v, v};
            v2 t01 = sa2 * (v2){bb.x, bb.y}; t01 = vv2 * (v2){k4.x, k4.y} + t01; S01 = S01 * (v2){w4.x, w4.y} + t01;
            v2 t23 = sa2 * (v2){bb.z, bb.w}; t23 = vv2 * (v2){k4.z, k4.w} + t23; S23 = S23 * (v2){w4.z, w4.w} + t23;
            v2 e = (v2){r4.x, r4.y} * S01; e = (v2){r4.z, r4.w} * S23 + e;
            const float y = ar16(e.x + e.y);
            const int t = t0 + tt;
            if ((t & 15) == cg) ykeep = y;
            if ((t & 15) == 15) Y[((size_t)b * SEQ + (t - 15) + cg) * 384 + h * 64 + row] = ykeep;
            if (tt < 7) { kap = nkap; bb = nbb; w4 = nw4; k4 = nk4; r4 = nr4; v = nv; }
        }
        LDS_WAIT();
      }
    }
}
#define MOBA_LOAD(jj, ss) do { const int key0_ = (jj) * 256 + (ss) * 32; \
    _Pragma("unroll") for (int kt = 0; kt < 2; ++kt) { const bf16_t* krow = base + (size_t)(key0_ + 16 * kt + fr) * 1152 + 384 + h * 64; Kn[2 * kt] = *(const bf16x8*)(krow + 8 * fq); Kn[2 * kt + 1] = *(const bf16x8*)(krow + 32 + 8 * fq); } \
    _Pragma("unroll") for (int k = 0; k < 4; ++k) { const int u = lane + 64 * k; Vn[k] = *(const u32x4*)(base + (size_t)(key0_ + (u >> 3)) * 1152 + 768 + h * 64 + (u & 7) * 8); } } while (0)
__device__ __forceinline__ void moba_task(const bf16_t* QKV, const float* KBAR, bf16_t* MIXCAT, int task, int lane, LAS unsigned char* vl) {
    const int fr = lane & 15, fq = lane >> 4;
    const int qb = 7 - task / 768; int rem = task % 768; const int b = rem / 96; rem %= 96; const int h = rem / 16, qg = rem % 16;
    const int q0 = qb * 256 + qg * 16, qpos = q0 + fr;
    const bf16_t* base = QKV + (size_t)b * SEQ * 1152;
    const bf16_t* qrow = base + (size_t)qpos * 1152 + h * 64;
    bf16x8 Qf[2]; Qf[0] = *(const bf16x8*)(qrow + 8 * fq); Qf[1] = *(const bf16x8*)(qrow + 32 + 8 * fq);
    unsigned selmask = 0, pm = 1u << qb;
    { float qv[16]; unpack8(__builtin_bit_cast(u32x4, Qf[0]), qv); unpack8(__builtin_bit_cast(u32x4, Qf[1]), qv + 8);
      float sc[7];
#pragma unroll
      for (int j = 0; j < 7; ++j) { sc[j] = -INFINITY;
        if (j < qb) { const float* kb = KBAR + ((b * NH + h) * 8 + j) * 64; const f32x4 k0 = *(const f32x4*)(kb + 8 * fq), k1 = *(const f32x4*)(kb + 8 * fq + 4), k2 = *(const f32x4*)(kb + 32 + 8 * fq), k3 = *(const f32x4*)(kb + 36 + 8 * fq);
            float s = qv[0] * k0.x + qv[1] * k0.y + qv[2] * k0.z + qv[3] * k0.w + qv[4] * k1.x + qv[5] * k1.y + qv[6] * k1.z + qv[7] * k1.w
                    + qv[8] * k2.x + qv[9] * k2.y + qv[10] * k2.z + qv[11] * k2.w + qv[12] * k3.x + qv[13] * k3.y + qv[14] * k3.z + qv[15] * k3.w;
            s += __shfl_xor(s, 16); s += __shfl_xor(s, 32); sc[j] = s; } }
#pragma unroll
      for (int j = 0; j < 7; ++j) { int rank = 0;
#pragma unroll
        for (int i = 0; i < 7; ++i) if (i != j) rank += (i < qb) && (sc[i] > sc[j] || (sc[i] == sc[j] && i < j));
        const bool sel = (j < qb) && (rank < 3);
        if (sel) selmask |= 1u << j;
        if (__ballot(sel) != 0ull) pm |= 1u << j; } }
    pm = __builtin_amdgcn_readfirstlane(pm);
    const int n_own = (qg * 16 + 15) / 32 + 1;
    float m = -1e30f, l = 0.f; f32x4 O[4];
#pragma unroll
    for (int d = 0; d < 4; ++d) O[d] = (f32x4){0.f, 0.f, 0.f, 0.f};
    int j = __builtin_ctz(pm); pm &= pm - 1; int st = 0, ns = (j == qb) ? n_own : 8;
    bf16x8 Kn[4]; u32x4 Vn[4];
    MOBA_LOAD(j, st);
    for (;;) {
        bf16x8 Kc[4];
#pragma unroll
        for (int i = 0; i < 4; ++i) Kc[i] = Kn[i];
#pragma unroll
        for (int k = 0; k < 4; ++k) { const int u = lane + 64 * k; *(LAS u32x4*)(vl + (u >> 3) * 144 + (u & 7) * 16) = Vn[k]; }
        int j2 = j, st2 = st + 1; bool more = true;
        if (st2 == ns) { if (pm == 0u) more = false; else { j2 = __builtin_ctz(pm); pm &= pm - 1; st2 = 0; ns = (j2 == qb) ? n_own : 8; } }
        if (more) MOBA_LOAD(j2, st2);
        const bool own = (j == qb); const bool rowsel = own || ((selmask >> j) & 1u);
        const int key0 = j * 256 + st * 32;
        f32x4 sv[2];
#pragma unroll
        for (int kt = 0; kt < 2; ++kt) { f32x4 a = {0.f, 0.f, 0.f, 0.f};
            a = __builtin_amdgcn_mfma_f32_16x16x32_bf16(Kc[2 * kt], Qf[0], a, 0, 0, 0);
            a = __builtin_amdgcn_mfma_f32_16x16x32_bf16(Kc[2 * kt + 1], Qf[1], a, 0, 0, 0); sv[kt] = a; }
        float pv[8]; float mx = -INFINITY;
#pragma unroll
        for (int kt = 0; kt < 2; ++kt)
#pragma unroll
            for (int r = 0; r < 4; ++r) { const int kp = key0 + 16 * kt + 4 * fq + r; const bool ok = rowsel && (!own || kp <= qpos);
                const float x = ok ? sv[kt][r] * 0.125f : -INFINITY; pv[kt * 4 + r] = x; mx = fmaxf(mx, x); }
        mx = fmaxf(mx, __shfl_xor(mx, 16)); mx = fmaxf(mx, __shfl_xor(mx, 32));
        const float mnew = fmaxf(m, mx), alpha = __expf(m - mnew); m = mnew;
        float ps = 0.f;
#pragma unroll
        for (int i = 0; i < 8; ++i) { pv[i] = __expf(pv[i] - mnew); ps += pv[i]; }
        l = l * alpha + ps;
#pragma unroll
        for (int d = 0; d < 4; ++d) O[d] = O[d] * alpha;
        const bf16x8 Pf = pack8(pv);
#pragma unroll
        for (int d = 0; d < 4; ++d) { const LAS bf16_t* vp = (const LAS bf16_t*)(vl + (16 * d + fr) * 2); u32x4 w;
            w.x = (unsigned)vp[(4 * fq + 0) * 72] | ((unsigned)vp[(4 * fq + 1) * 72] << 16); w.y = (unsigned)vp[(4 * fq + 2) * 72] | ((unsigned)vp[(4 * fq + 3) * 72] << 16);
            w.z = (unsigned)vp[(16 + 4 * fq + 0) * 72] | ((unsigned)vp[(16 + 4 * fq + 1) * 72] << 16); w.w = (unsigned)vp[(16 + 4 * fq + 2) * 72] | ((unsigned)vp[(16 + 4 * fq + 3) * 72] << 16);
            O[d] = __builtin_amdgcn_mfma_f32_16x16x32_bf16(__builtin_bit_cast(bf16x8, w), Pf, O[d], 0, 0, 0); }
        if (!more) break;
        j = j2; st = st2;
    }
    l += __shfl_xor(l, 16); l += __shfl_xor(l, 32); const float inv = 1.0f / l;
    bf16_t* orow = MIXCAT + ((size_t)b * SEQ + qpos) * DM + 384 + h * 64 + 4 * fq;
#pragma unroll
    for (int d = 0; d < 4; ++d) *(u32x2*)(orow + 16 * d) = pack4(O[d][0] * inv, O[d][1] * inv, O[d][2] * inv, O[d][3] * inv);
}
__device__ __forceinline__ void rwkv_post(const Lay& L, const float* Y, const bf16_t* OPS, const float* RK, bf16_t* MIXCAT, int gw, int ngw, int lane) {
    const int cg = lane & 15, sub = lane >> 4;
    for (int it = gw; it < MTOK * NH / 4; it += ngw) {
        const int pr = it * 4 + sub, tok = pr / NH, h = pr % NH, c0 = 64 * h + 4 * cg;
        const f32x4 y = *(const f32x4*)(Y + (size_t)tok * 384 + c0);
        const float mean = ar16((y.x + y.y) + (y.z + y.w)) * (1.0f / 64.0f);
        const f32x4 d = y - mean; const float var = ar16((d.x * d.x + d.y * d.y) + (d.z * d.z + d.w * d.w)) * (1.0f / 64.0f);
        const float rstd = rsqrtf(var + 64e-5f), rk = RK[(size_t)tok * 8 + h];
        const int bh = (tok >> 11) * NH + h, s = tok & (SEQ - 1);
        float v[4], g[4]; unpack4(*(const u32x2*)(OPS + ((size_t)bh * SEQ + s) * 384 + 5 * 64 + 4 * cg), v);
        bf16_t* mp = MIXCAT + (size_t)tok * DM + c0; unpack4(*(const u32x2*)mp, g);
        const f32x4 lg = *(const f32x4*)(L.lnx_g + c0), lb = *(const f32x4*)(L.lnx_b + c0);
        *(u32x2*)mp = pack4((d.x * rstd * lg.x + lb.x + rk * v[0]) * g[0], (d.y * rstd * lg.y + lb.y + rk * v[1]) * g[1], (d.z * rstd * lg.z + lb.z + rk * v[2]) * g[2], (d.w * rstd * lg.w + lb.w + rk * v[3]) * g[3]);
    }
}
__device__ __forceinline__ int grab(unsigned* ctr) { int t = 0; if ((threadIdx.x & 63) == 0) t = (int)atomicAdd(ctr, 1u); return __builtin_amdgcn_readfirstlane(t); }


#define XB_TMO      128
#define XB_XCNT(j)  (256  + 64 * (j))
#define XB_XSUB(j)  (1280 + 64 * (j))
#define XB_XGEN(j)  (2304 + 64 * (j))
#define XB_TOP      3328
#define XB_TOPGEN   3392
#define XCD_BAR_WORDS 3456
#define XB_SPIN_CAP (1u << 18)
__device__ __forceinline__ unsigned xb_ld(unsigned* p)              { return __hip_atomic_load(p, __ATOMIC_RELAXED, __HIP_MEMORY_SCOPE_AGENT); }
__device__ __forceinline__ unsigned xb_add(unsigned* p, unsigned v) { return __hip_atomic_fetch_add(p, v, __ATOMIC_RELAXED, __HIP_MEMORY_SCOPE_AGENT); }
__device__ __forceinline__ unsigned xb_xcc_id() { return (unsigned)__builtin_amdgcn_s_getreg((3 << 11) | 20) & 0xFu; }
#define XB_SPIN(cond, bar) do { unsigned _sp = 0; while (cond) { __builtin_amdgcn_s_sleep(1); \
    if ((++_sp & 255u) == 0u) { if (xb_ld(&(bar)[XB_TMO])) break; if (_sp > XB_SPIN_CAP) { atomicAdd(&(bar)[XB_TMO], 1u); break; } } } } while (0)
struct XcdBarrier { unsigned* bar; unsigned x; volatile LAS unsigned* st; };
__device__ __forceinline__ void xcd_barrier_complete(unsigned* bar, unsigned x, unsigned& nloc, unsigned& nx) {
    const unsigned G = gridDim.x * gridDim.y * gridDim.z;
    unsigned sum, cnt, mine, sp = 0u;
    for (;;) {
        sum = 0u; cnt = 0u; mine = 0u;
#pragma unroll
        for (unsigned j = 0; j < 16; ++j) { const unsigned c = xb_ld(&bar[XB_XCNT(j)]); sum += c; cnt += (c > 0u) ? 1u : 0u; mine = (j == x) ? c : mine; }
        if (sum == G) break;
        __builtin_amdgcn_s_sleep(1);
        if ((++sp & 255u) == 0u) { if (xb_ld(&bar[XB_TMO])) break; if (sp > XB_SPIN_CAP) { atomicAdd(&bar[XB_TMO], 1u); break; } }
    }
    nloc = mine > 0u ? mine : 1u; nx = cnt > 0u ? cnt : 1u;
}
__device__ __forceinline__ void xcd_barrier(const XcdBarrier& b) {
    asm volatile("s_waitcnt vmcnt(0)" ::: "memory");
    __syncthreads();
    if (threadIdx.x == 0) {
        unsigned* bar = b.bar;
        __builtin_amdgcn_s_waitcnt(0);
        unsigned nloc = b.st[0], nx = b.st[1];
        if (nloc == 0u) { xcd_barrier_complete(bar, b.x, nloc, nx); b.st[0] = nloc; b.st[1] = nx; }
        const unsigned old = xb_add(&bar[XB_XSUB(b.x)], 1u);
        const unsigned gen = old / nloc;
        if (old + 1u == (gen + 1u) * nloc) {
            __builtin_amdgcn_fence(__ATOMIC_RELEASE, "agent");
            asm volatile("s_waitcnt vmcnt(0)" ::: "memory");
            const unsigned og = xb_add(&bar[XB_TOP], 1u);
            const unsigned tg = og / nx;
            if (og + 1u == (tg + 1u) * nx) xb_add(&bar[XB_TOPGEN], 1u);
            else XB_SPIN(xb_ld(&bar[XB_TOPGEN]) == tg, bar);
            __builtin_amdgcn_fence(__ATOMIC_ACQUIRE, "agent");
            xb_add(&bar[XB_XGEN(b.x)], 1u);
            asm volatile("s_waitcnt vmcnt(0)" ::: "memory");
        } else {
            XB_SPIN(xb_ld(&bar[XB_XGEN(b.x)]) == gen, bar);
            __builtin_amdgcn_fence(__ATOMIC_ACQUIRE, "agent");
            asm volatile("s_waitcnt vmcnt(0)" ::: "memory");
        }
    }
    __syncthreads();
}
typedef const __attribute__((address_space(4))) Params* KP;
__device__ __forceinline__ KP kargs() { KP p = (KP)__builtin_amdgcn_kernarg_segment_ptr(); asm volatile("" : "+s"(p)); return p; }
__device__ __forceinline__ int otid() { int t = threadIdx.x; asm volatile("" : "+v"(t)); return t; }
__device__ __forceinline__ Lay make_lay(KP kp, int l) {
    Lay L; unsigned char* ws = kp->ws; const unsigned char* wl = ws + WS_W + (size_t)l * WL_SIZE;
    L.mu = kp->in[3] + l * 1408; L.w0 = kp->in[4] + l * 384; L.a0 = kp->in[6] + l * 384; L.k_k = kp->in[9] + l * 384; L.k_a = kp->in[10] + l * 384; L.r_k = kp->in[11] + l * 384;
    L.lnx_g = kp->in[12] + l * 384; L.lnx_b = kp->in[13] + l * 384; L.gln_g = kp->in[14] + l * 256; L.gln_b = kp->in[15] + l * 256; L.gw_s = kp->in[16] + (size_t)l * 4 * 128 * 128; L.gb_s = kp->in[17] + l * 512;
    L.w2T = (const bf16_t*)(wl + WL_W2); L.a2T = (const bf16_t*)(wl + WL_A2); L.g2T = (const bf16_t*)(wl + WL_G2); return L;
}
#define PHASE_IDS() const int tid = otid(), lane = tid & 63, wave = __builtin_amdgcn_readfirstlane(tid >> 6), bid = blockIdx.x, G = gridDim.x, gw = bid * 8 + wave, ngw = G * 8; (void)lane; (void)wave; (void)gw; (void)ngw; (void)G
__global__ void __launch_bounds__(512, 2) fwd_megakernel(Params Pdummy) {
    extern __shared__ __attribute__((aligned(16))) unsigned char lds_raw[];
    cg::grid_group grid = cg::this_grid();
    LAS unsigned char* lds = (LAS unsigned char*)lds_raw;
    if (threadIdx.x < 2) ((volatile LAS unsigned*)(lds + 131072))[threadIdx.x] = 0u;
    __syncthreads();
    if (threadIdx.x == 0) { KP kp0 = kargs(); (void)xb_add(&((unsigned*)(kp0->ws + WS_BAR))[XB_XCNT(xb_xcc_id())], 1u); }
#define GRID_BAR() do { KP kpb_ = kargs(); XcdBarrier b_; b_.bar = (unsigned*)(kpb_->ws + WS_BAR); b_.x = xb_xcc_id(); b_.st = (volatile LAS unsigned*)(lds + 131072); xcd_barrier(b_); } while (0)

    { KP kp = kargs(); PHASE_IDS();
      p0_weights(kp->in[2], kp->in[18], kp->in[21], kp->in[22], kp->in[5], kp->in[7], kp->in[8], kp->ws, lds, gw, ngw, wave, lane);
      row_phase(kp->in[0], nullptr, nullptr, nullptr, kp->in[1], (bf16_t*)(kp->ws + WS_XB), gw, ngw, lane); }
    grid.sync();

#pragma unroll 1
    for (int l = 0; l < NLAYER; ++l) {
        { KP kp = kargs(); unsigned char* ws = kp->ws; const unsigned char* wl = ws + WS_W + (size_t)l * WL_SIZE;
          pg8::Gemm g{(const bf16_t*)(ws + WS_XB), (const bf16_t*)(wl + WL_IN), MTOK, 3072, 1024}; pg8::StaticOrder S; S.init(MTOK, 3072, gridDim.x, blockIdx.x);
          pg8::EpiProj E{(bf16_t*)(ws + WS_RW), (bf16_t*)(ws + WS_QKV), (bf16_t*)(ws + WS_GM)};
          pg8::gemm_phase<pg8::EpiProj, pg8::StaticOrder, false>(lds, g, S, E, nullptr); }
        GRID_BAR();
        { KP kp = kargs(); PHASE_IDS(); unsigned char* ws = kp->ws; const Lay L = make_lay(kp, l);
          bf16_t* MIXCAT = (bf16_t*)(ws + WS_MIXCAT);
          if (gw < 384) kbar_task((const bf16_t*)(ws + WS_QKV), (float*)(ws + WS_KBAR), gw, lane);
          rwkv_prep_block(L, (const bf16_t*)(ws + WS_RW), (bf16_t*)(ws + WS_OPS), MIXCAT, (float*)(ws + WS_RK), bid, lds, tid, wave, lane); }
        GRID_BAR();
        { const int rep = 0;
        { KP kp = kargs(); PHASE_IDS(); unsigned char* ws = kp->ws;
          if (bid >= 192) { const Lay L = make_lay(kp, l);
              gmlp_task(L, (const bf16_t*)(ws + WS_GM), (bf16_t*)(ws + WS_MIXCAT), 2 * (bid - 192), lds, wave, lane);
              gmlp_task(L, (const bf16_t*)(ws + WS_GM), (bf16_t*)(ws + WS_MIXCAT), 2 * (bid - 192) + 1, lds, wave, lane); }
          if (bid < 192 && wave < 4) { const int xcd = bid & 7, k = bid >> 3, bh = xcd * 6 + (k >> 2), rg = k & 3;
              __builtin_amdgcn_s_setprio(3);
              scan_unit((const bf16_t*)(ws + WS_OPS) + (size_t)bh * SEQ * 384, (float*)(ws + WS_Y), bh / NH, bh % NH, 16 * rg + 4 * wave + (lane >> 4), lane, (LAS float*)(lds + 36864 + wave * 12288));
              __builtin_amdgcn_s_setprio(0); }
          unsigned* ctr = (unsigned*)(ws + WS_CTL) + 64 * (2 * l + 1 + 4 * rep);
          for (;;) { const int t = grab(ctr); if (t >= 6144) break; moba_task((const bf16_t*)(ws + WS_QKV), (const float*)(ws + WS_KBAR), (bf16_t*)(ws + WS_MIXCAT), t, lane, lds + wave * 4608); } } }
        GRID_BAR();
        { KP kp = kargs(); PHASE_IDS(); unsigned char* ws = kp->ws; const Lay L = make_lay(kp, l);
          rwkv_post(L, (const float*)(ws + WS_Y), (const bf16_t*)(ws + WS_OPS), (const float*)(ws + WS_RK), (bf16_t*)(ws + WS_MIXCAT), gw, ngw, lane); }
        GRID_BAR();
        { KP kp = kargs(); unsigned char* ws = kp->ws; const unsigned char* wl = ws + WS_W + (size_t)l * WL_SIZE;
          pg8::Gemm g{(const bf16_t*)(ws + WS_MIXCAT), (const bf16_t*)(wl + WL_OUT), MTOK, 1024, 1024}; pg8::StaticOrder S; S.init(MTOK, 1024, gridDim.x, blockIdx.x); pg8::EpiF32 E{(float*)(ws + WS_MIXO), 1024};
          pg8::gemm_phase<pg8::EpiF32, pg8::StaticOrder, false>(lds, g, S, E, nullptr); }
        GRID_BAR();
        { KP kp = kargs(); PHASE_IDS(); unsigned char* ws = kp->ws;
          row_phase(l == 0 ? kp->in[0] : (const float*)kp->out, (const float*)(ws + WS_MIXO), kp->in[19] + l * DM, kp->out, kp->in[20] + l * DM, (bf16_t*)(ws + WS_XA), gw, ngw, lane); }
        GRID_BAR();
        { KP kp = kargs(); unsigned char* ws = kp->ws; const unsigned char* wl = ws + WS_W + (size_t)l * WL_SIZE;
          pg8::Gemm g{(const bf16_t*)(ws + WS_XA), (const bf16_t*)(wl + WL_FF), MTOK, 5632, 1024}; pg8::StaticOrder S; S.init(MTOK, 5632, gridDim.x, blockIdx.x); pg8::EpiSwiglu E{(bf16_t*)(ws + WS_FF)};
          pg8::gemm_phase<pg8::EpiSwiglu, pg8::StaticOrder, false>(lds, g, S, E, nullptr); }
        GRID_BAR();
        { KP kp = kargs(); unsigned char* ws = kp->ws; const unsigned char* wl = ws + WS_W + (size_t)l * WL_SIZE;
          pg8::Gemm g{(const bf16_t*)(ws + WS_FF), (const bf16_t*)(wl + WL_FF2), MTOK, 1024, DFF}; pg8::StaticOrder S; S.init(MTOK, 1024, gridDim.x, blockIdx.x); pg8::EpiF32 E{(float*)(ws + WS_MIXO2), 1024};
          pg8::gemm_phase<pg8::EpiF32, pg8::StaticOrder, false>(lds, g, S, E, nullptr); }
        GRID_BAR();
        { KP kp = kargs(); PHASE_IDS(); unsigned char* ws = kp->ws;
          row_phase((const float*)kp->out, (const float*)(ws + WS_MIXO2), kp->in[23] + l * DM, kp->out, l + 1 < NLAYER ? kp->in[1] + (l + 1) * DM : nullptr, l + 1 < NLAYER ? (bf16_t*)(ws + WS_XB) : nullptr, gw, ngw, lane); }
        if (l + 1 < NLAYER) GRID_BAR();
    }
}

extern "C" void kernel_launch(void* const* d_in, const int* in_sizes, int n_in, void* d_out, int out_size, void* d_ws, size_t ws_size, hipStream_t stream) {
    static int grid_blocks = 0;
    if (!grid_blocks) {
        int dev = 0, cus = 0, per_cu = 0;
        (void)hipGetDevice(&dev); (void)hipDeviceGetAttribute(&cus, hipDeviceAttributeMultiprocessorCount, dev);
        (void)hipFuncSetAttribute((const void*)fwd_megakernel, hipFuncAttributeMaxDynamicSharedMemorySize, LDS_BYTES);
        (void)hipOccupancyMaxActiveBlocksPerMultiprocessor(&per_cu, (const void*)fwd_megakernel, 512, LDS_BYTES);
        if (per_cu < 1) { fprintf(stderr, "kernel_launch: occupancy query says %d blocks per CU\n", per_cu); per_cu = 1; }
        grid_blocks = cus;
        if (ws_size < WS_END) fprintf(stderr, "kernel_launch: workspace too small: %zu < %zu\n", ws_size, (size_t)WS_END);
    }
    (void)hipMemsetAsync((unsigned char*)d_ws + WS_CTL, 0, CTL_ZERO_BYTES, stream);
    Params p{};
    for (int i = 0; i < 24; ++i) p.in[i] = (const float*)d_in[i];
    p.out = (float*)d_out; p.ws = (unsigned char*)d_ws;
    void* args[] = {&p};
    hipError_t e = hipLaunchCooperativeKernel((const void*)fwd_megakernel, dim3(grid_blocks), dim3(512), args, LDS_BYTES, stream);
    if (e != hipSuccess) fprintf(stderr, "cooperative launch failed: %s (grid %d)\n", hipGetErrorString(e), grid_blocks);
}
```
